# Optimizing an MI355X kernel written in HIP

```python
import math
import jax, jax.numpy as jnp
from jax import lax
import numpy as np

D_MODEL = 1024
BATCH = 16
SEQ = 2048
DEPTH = 2

GRID_W = 64
ROPE_THETA = 10000.0
Q_BLOCK = 128
EPS = 1e-6
PLE_DIM = 256

MLA_HEADS = 8
MLA_Q_LORA = 256
MLA_KV_LORA = 128
MLA_NOPE = 64
MLA_ROPE = 32
MLA_V = 64

GLA_HEADS = 4
GLA_DK = 64
GLA_DV = 128
GLA_GATE_RANK = 16
GLA_GATE_NORM = 16.0
GLA_CHUNK = 64

GQA_HEADS = 16
GQA_KV_HEADS = 4
GQA_HEAD_DIM = 64

N_EXPERTS = 16
EC_CAPACITY_FACTOR = 2
EXPERT_FF = 1024

D_MIX = MLA_HEADS * MLA_V + GLA_HEADS * GLA_DV
EVEN_SPLITS = (MLA_Q_LORA, MLA_KV_LORA, MLA_ROPE,
               GLA_HEADS * GLA_DK, GLA_HEADS * GLA_DK, GLA_HEADS * GLA_DV,
               2 * GLA_GATE_RANK, GLA_HEADS * GLA_DV)
ODD_SPLITS = (GQA_HEADS * GQA_HEAD_DIM, GQA_KV_HEADS * GQA_HEAD_DIM, GQA_KV_HEADS * GQA_HEAD_DIM)
N_EVEN = (DEPTH + 1) // 2
N_ODD = DEPTH // 2
DEEPNORM_ALPHA = (2.0 * DEPTH) ** 0.25
DEEPNORM_BETA = (8.0 * DEPTH) ** -0.25

kernel_name = "hybrid_mla_gla_gqa_ecmoe_deepnorm"


def _split(h, sizes):
    offs = np.cumsum(sizes)[:-1].tolist()
    return jnp.split(h, offs, axis=-1)


def rms_norm(x, g):
    x32 = x.astype(jnp.float32)
    y = x32 * lax.rsqrt(jnp.mean(x32 * x32, axis=-1, keepdims=True) + EPS)
    return (y * g.astype(jnp.float32)).astype(x.dtype)


def layer_norm(x, g, b):
    x32 = x.astype(jnp.float32)
    mu = jnp.mean(x32, axis=-1, keepdims=True)
    xc = x32 - mu
    var = jnp.mean(xc * xc, axis=-1, keepdims=True)
    y = xc * lax.rsqrt(var + EPS) * g.astype(jnp.float32) + b.astype(jnp.float32)
    return y.astype(x.dtype)


def axial_rope(seq, rot_dim):
    rows = seq // GRID_W
    row = jnp.repeat(jnp.arange(rows, dtype=jnp.float32), GRID_W)
    col = jnp.tile(jnp.arange(GRID_W, dtype=jnp.float32), rows)
    axis_dim = rot_dim // 2
    inv = ROPE_THETA ** (-jnp.arange(0, axis_dim, 2, dtype=jnp.float32) / axis_dim)
    ang = jnp.concatenate([row[:, None] * inv, col[:, None] * inv], axis=-1)
    return jnp.cos(ang), jnp.sin(ang)


def apply_rope(x, cos, sin):
    half = x.shape[-1] // 2
    c = cos.astype(x.dtype)
    s = sin.astype(x.dtype)
    x1, x2 = x[..., :half], x[..., half:]
    return jnp.concatenate([x1 * c - x2 * s, x1 * s + x2 * c], axis=-1)


def _to_blocks(t):
    b, s = t.shape[:2]
    nb = s // Q_BLOCK
    return t.reshape((b, nb, Q_BLOCK) + t.shape[2:]).swapaxes(0, 1)


def _from_blocks(t):
    nb, b, qb = t.shape[:3]
    return t.swapaxes(0, 1).reshape((b, nb * qb) + t.shape[3:])


def mla_attention(q_nope, q_pe, k_nope, k_pe, v):
    scale = (MLA_NOPE + MLA_ROPE) ** -0.5

    def block(args):
        qn, qp = args
        s = (jnp.einsum('bqhd,bkhd->bhqk', qn, k_nope)
             + jnp.einsum('bqhd,bkd->bhqk', qp, k_pe)) * scale
        pr = jax.nn.softmax(s.astype(jnp.float32), axis=-1).astype(v.dtype)
        return jnp.einsum('bhqk,bkhd->bqhd', pr, v)

    o = lax.map(block, (_to_blocks(q_nope), _to_blocks(q_pe)))
    return _from_blocks(o)


def gla_chunked(q, k, v, log_a):
    b, s, h, dk = q.shape
    dv = v.shape[-1]
    n = s // GLA_CHUNK
    L = GLA_CHUNK

    def chunk(t):
        return t.astype(jnp.float32).reshape(b, n, L, h, t.shape[-1]).transpose(0, 3, 1, 2, 4)

    qc, kc, vc, lac = chunk(q), chunk(k), chunk(v), chunk(log_a)
    cum = jnp.cumsum(lac, axis=-2)
    qg = qc * jnp.exp(cum)
    kg = kc * jnp.exp(-cum)
    tri = jnp.tril(jnp.ones((L, L), dtype=bool))
    att = jnp.where(tri, jnp.einsum('bhnld,bhnmd->bhnlm', qg, kg), 0.0)
    o_intra = jnp.einsum('bhnlm,bhnme->bhnle', att, vc)
    last = cum[..., -1:, :]
    u = jnp.einsum('bhnld,bhnle->bhnde', kc * jnp.exp(last - cum), vc)
    decay = jnp.exp(last[..., 0, :])

    def step(state, inp):
        d, du = inp
        return d[..., None] * state + du, state

    init = jnp.zeros((b, h, dk, dv), jnp.float32)
    _, s_prev = lax.scan(step, init, (jnp.moveaxis(decay, 2, 0), jnp.moveaxis(u, 2, 0)))
    o_inter = jnp.einsum('bhnld,nbhde->bhnle', qg, s_prev)
    o = (o_intra + o_inter).transpose(0, 2, 3, 1, 4).reshape(b, s, h, dv)
    return o.astype(v.dtype)


def even_mixer(x, w_in, mla_q_norm, w_uq, mla_kv_norm, w_ukv,
               gla_gate_w_fwd, gla_gate_b_fwd, gla_gate_w_bwd, gla_gate_b_bwd, gla_norm,
               cos_a, sin_a):
    b, s, _ = x.shape
    h = x @ w_in
    c_q, c_kv, k_pe, gq, gk, gv, g_lr, gr = _split(h, EVEN_SPLITS)

    q = (rms_norm(c_q, mla_q_norm) @ w_uq).reshape(b, s, MLA_HEADS, MLA_NOPE + MLA_ROPE)
    q_nope = q[..., :MLA_NOPE]
    q_pe = apply_rope(q[..., MLA_NOPE:], cos_a[:, None, :], sin_a[:, None, :])
    kv = (rms_norm(c_kv, mla_kv_norm) @ w_ukv).reshape(b, s, MLA_HEADS, MLA_NOPE + MLA_V)
    k_nope, v_mla = kv[..., :MLA_NOPE], kv[..., MLA_NOPE:]
    k_pe = apply_rope(k_pe, cos_a, sin_a)
    o_mla = mla_attention(q_nope, q_pe, k_nope, k_pe, v_mla).reshape(b, s, MLA_HEADS * MLA_V)

    qh = (gq * (GLA_DK ** -0.5)).reshape(b, s, GLA_HEADS, GLA_DK)
    kh = gk.reshape(b, s, GLA_HEADS, GLA_DK)
    vh = gv.reshape(b, s, GLA_HEADS, GLA_DV)
    lr_f, lr_b = g_lr[..., :GLA_GATE_RANK], g_lr[..., GLA_GATE_RANK:]
    la_f = (jax.nn.log_sigmoid((lr_f @ gla_gate_w_fwd + gla_gate_b_fwd).astype(jnp.float32))
            / GLA_GATE_NORM).reshape(b, s, GLA_HEADS, GLA_DK)
    la_b = (jax.nn.log_sigmoid((lr_b @ gla_gate_w_bwd + gla_gate_b_bwd).astype(jnp.float32))
            / GLA_GATE_NORM).reshape(b, s, GLA_HEADS, GLA_DK)
    o_f = gla_chunked(qh, kh, vh, la_f)
    flip = lambda t: jnp.flip(t, axis=1)
    o_b = flip(gla_chunked(flip(qh), flip(kh), flip(vh), flip(la_b)))
    o_gla = rms_norm(o_f + o_b, gla_norm).reshape(b, s, GLA_HEADS * GLA_DV) * jax.nn.silu(gr)

    return jnp.concatenate([o_mla, o_gla], axis=-1)


def odd_mixer(x, w_in, gqa_q_norm, gqa_k_norm, cos_c, sin_c):
    b, s, _ = x.shape
    g = GQA_HEADS // GQA_KV_HEADS
    q, k, v = _split(x @ w_in, ODD_SPLITS)
    q = rms_norm(q.reshape(b, s, GQA_HEADS, GQA_HEAD_DIM), gqa_q_norm)
    k = rms_norm(k.reshape(b, s, GQA_KV_HEADS, GQA_HEAD_DIM), gqa_k_norm)
    v = v.reshape(b, s, GQA_KV_HEADS, GQA_HEAD_DIM)
    q = apply_rope(q, cos_c[:, None, :], sin_c[:, None, :]).reshape(b, s, GQA_KV_HEADS, g, GQA_HEAD_DIM)
    k = apply_rope(k, cos_c[:, None, :], sin_c[:, None, :])
    scale = GQA_HEAD_DIM ** -0.5

    def block(qb):
        sc = jnp.einsum('bqkgd,bskd->bkgqs', qb, k) * scale
        pr = jax.nn.softmax(sc.astype(jnp.float32), axis=-1).astype(v.dtype)
        return jnp.einsum('bkgqs,bskd->bqkgd', pr, v)

    o = _from_blocks(lax.map(block, _to_blocks(q)))
    return o.reshape(b, s, GQA_HEADS * GQA_HEAD_DIM)


def expert_choice_moe(x, router_w, w1, w3, w2):
    b, s, d = x.shape
    cap = EC_CAPACITY_FACTOR * s // N_EXPERTS
    aff = jax.nn.softmax(jnp.einsum('bsd,de->bse', x, router_w).astype(jnp.float32), axis=-1)
    gates, idx = lax.top_k(aff.transpose(0, 2, 1), cap)
    xg = jax.vmap(lambda xb, ib: xb[ib])(x, idx)
    hid = jax.nn.silu(jnp.einsum('becd,edf->becf', xg, w1)) * jnp.einsum('becd,edf->becf', xg, w3)
    ye = jnp.einsum('becf,efd->becd', hid, w2) * gates[..., None].astype(x.dtype)
    return jax.vmap(lambda yb, ib: jnp.zeros((s, d), x.dtype).at[ib.reshape(-1)].add(yb.reshape(-1, d)))(ye, idx)


def setup_inputs(seed: int = 0) -> dict:
    key = jax.random.key(seed)
    ks = iter(jax.random.split(key, 40))
    f32 = jnp.float32

    def nrm(shape, scale):
        return jax.random.normal(next(ks), shape, f32) * scale

    def gain(shape):
        return 1.0 + 0.02 * jax.random.normal(next(ks), shape, f32)

    d_even_in = sum(EVEN_SPLITS)
    d_odd_in = sum(ODD_SPLITS)
    NE, NO = N_EVEN, N_ODD
    return {
        "x": nrm((BATCH, SEQ, D_MODEL), 1.0),
        "p": nrm((DEPTH, BATCH, SEQ, PLE_DIM), 1.0),
        "w_in_even": nrm((NE, D_MODEL, d_even_in), D_MODEL ** -0.5),
        "mla_q_norm": gain((NE, MLA_Q_LORA)),
        "w_uq": nrm((NE, MLA_Q_LORA, MLA_HEADS * (MLA_NOPE + MLA_ROPE)), MLA_Q_LORA ** -0.5),
        "mla_kv_norm": gain((NE, MLA_KV_LORA)),
        "w_ukv": nrm((NE, MLA_KV_LORA, MLA_HEADS * (MLA_NOPE + MLA_V)), MLA_KV_LORA ** -0.5),
        "gla_gate_w_fwd": nrm((NE, GLA_GATE_RANK, GLA_HEADS * GLA_DK), GLA_GATE_RANK ** -0.5),
        "gla_gate_b_fwd": nrm((NE, GLA_HEADS * GLA_DK), 0.1),
        "gla_gate_w_bwd": nrm((NE, GLA_GATE_RANK, GLA_HEADS * GLA_DK), GLA_GATE_RANK ** -0.5),
        "gla_gate_b_bwd": nrm((NE, GLA_HEADS * GLA_DK), 0.1),
        "gla_norm": gain((NE, GLA_DV)),
        "w_in_odd": nrm((NO, D_MODEL, d_odd_in), D_MODEL ** -0.5),
        "gqa_q_norm": gain((NO, GQA_HEAD_DIM)),
        "gqa_k_norm": gain((NO, GQA_HEAD_DIM)),
        "w_o": nrm((DEPTH, D_MIX, D_MODEL), D_MIX ** -0.5 * DEEPNORM_BETA),
        "ln1_g": gain((DEPTH, D_MODEL)),
        "ln1_b": nrm((DEPTH, D_MODEL), 0.02),
        "router_w": nrm((DEPTH, D_MODEL, N_EXPERTS), D_MODEL ** -0.5),
        "w1": nrm((DEPTH, N_EXPERTS, D_MODEL, EXPERT_FF), D_MODEL ** -0.5),
        "w3": nrm((DEPTH, N_EXPERTS, D_MODEL, EXPERT_FF), D_MODEL ** -0.5),
        "w2": nrm((DEPTH, N_EXPERTS, EXPERT_FF, D_MODEL), EXPERT_FF ** -0.5 * DEEPNORM_BETA),
        "ple_gate_w": nrm((DEPTH, D_MODEL, D_MODEL), D_MODEL ** -0.5),
        "ple_gate_b": nrm((DEPTH, D_MODEL), 0.02),
        "ple_w": nrm((DEPTH, PLE_DIM, D_MODEL), PLE_DIM ** -0.5 * DEEPNORM_BETA),
        "ln2_g": gain((DEPTH, D_MODEL)),
        "ln2_b": nrm((DEPTH, D_MODEL), 0.02),
    }


def reference(x, p, w_in_even, mla_q_norm, w_uq, mla_kv_norm, w_ukv,
              gla_gate_w_fwd, gla_gate_b_fwd, gla_gate_w_bwd, gla_gate_b_bwd, gla_norm,
              w_in_odd, gqa_q_norm, gqa_k_norm,
              w_o, ln1_g, ln1_b, router_w, w1, w3, w2,
              ple_gate_w, ple_gate_b, ple_w, ln2_g, ln2_b):
    seq = x.shape[1]
    cos_a, sin_a = axial_rope(seq, MLA_ROPE)
    cos_c, sin_c = axial_rope(seq, GQA_HEAD_DIM)
    for i in range(DEPTH):
        if i % 2 == 0:
            j = i // 2
            mix = even_mixer(x, w_in_even[j], mla_q_norm[j], w_uq[j], mla_kv_norm[j], w_ukv[j],
                             gla_gate_w_fwd[j], gla_gate_b_fwd[j], gla_gate_w_bwd[j], gla_gate_b_bwd[j],
                             gla_norm[j], cos_a, sin_a)
        else:
            j = i // 2
            mix = odd_mixer(x, w_in_odd[j], gqa_q_norm[j], gqa_k_norm[j], cos_c, sin_c)
        x = layer_norm(DEEPNORM_ALPHA * x + mix @ w_o[i], ln1_g[i], ln1_b[i])
        ffn = expert_choice_moe(x, router_w[i], w1[i], w3[i], w2[i])
        ple = jax.nn.sigmoid(x @ ple_gate_w[i] + ple_gate_b[i]) * (p[i] @ ple_w[i])
        x = layer_norm(DEEPNORM_ALPHA * x + ffn + ple, ln2_g[i], ln2_b[i])
    return x
```

```cpp
#include <hip/hip_runtime.h>
#include <hip/hip_cooperative_groups.h>
#include <cstdio>
#include <cstdint>
namespace cg = cooperative_groups;

typedef unsigned short bf16_t;
typedef short bf16x8 __attribute__((ext_vector_type(8)));
typedef short s16x4 __attribute__((ext_vector_type(4)));
typedef float f32x4 __attribute__((ext_vector_type(4)));
typedef unsigned u32x4 __attribute__((ext_vector_type(4)));
typedef unsigned u32x2 __attribute__((ext_vector_type(2)));
#define DI __device__ __forceinline__
#define MFMA16(a, b, c) __builtin_amdgcn_mfma_f32_16x16x32_bf16((a), (b), (c), 0, 0, 0)

constexpr int T = 32768, S = 2048, NB = 16, D = 1024, HE = 1984, NTHR = 256;
constexpr float EPS = 1e-6f;
constexpr float ALPHA = 1.41421356237f;
constexpr float LOG2E = 1.44269504089f;
constexpr long MiB = 1 << 20;
constexpr long M_BAR = 7 * MiB;
constexpr long M_QCTR = M_BAR + 16384;
constexpr int CTL_BYTES = 16384 + 32 * 8 * 64;
constexpr long OFF_WS = 0, OFF_MISC = 17 * MiB, OFF_WMOE = 25 * MiB, OFF_A = 121 * MiB, OFF_B = 313 * MiB, OFF_C = 441 * MiB, OFF_D = 505 * MiB, OFF_P = 569 * MiB, WS_END = 601 * MiB;
constexpr long W_INE = 0, W_UQ = 2031616, W_UKV = 2228224, W_INO = 2359296, W_O = 3932160, W_PG = 6029312, W_PW = 8126464;
constexpr long M_ROPEA = 0, M_ROPEC = 256 * 1024, M_AFF = 1 * MiB, M_SELI = 3 * MiB, M_SELG = 3 * MiB + 256 * 1024, M_INV = 4 * MiB, M_DEC = 6 * MiB;
constexpr int H_CQ = 0, H_CKV = 256, H_KPE = 384, H_GQ = 416, H_GK = 672, H_GV = 928, H_LR = 1440, H_GR = 1472;
constexpr int LDS_BYTES = 73728 + 1024 + 256;

struct Params {
    const float *x, *p, *w_in_even, *mla_q_norm, *w_uq, *mla_kv_norm, *w_ukv, *gw_f, *gb_f, *gw_b, *gb_b, *gla_norm, *w_in_odd, *gqa_q_norm, *gqa_k_norm,
        *w_o, *ln1_g, *ln1_b, *router_w, *w1, *w3, *w2, *pg_w, *pg_b, *ple_w, *ln2_g, *ln2_b;
    float* out; char* ws;
};

DI float bf2f(bf16_t v) { return __uint_as_float(((unsigned)v) << 16); }
typedef float f32x2 __attribute__((ext_vector_type(2)));
typedef __bf16 bf16v2 __attribute__((ext_vector_type(2)));
DI unsigned pk2(float lo, float hi) { f32x2 v = {lo, hi}; bf16v2 b = __builtin_convertvector(v, bf16v2); return __builtin_bit_cast(unsigned, b); }
DI bf16_t f2bf(float x) { return (bf16_t)(pk2(x, 0.f) & 0xffffu); }
DI void st_bf4(bf16_t* dst, f32x4 v) { u32x2 w; w[0] = pk2(v[0], v[1]); w[1] = pk2(v[2], v[3]); *(u32x2*)dst = w; }
DI void st_bf8(bf16_t* dst, f32x4 a, f32x4 b) { u32x4 w; w[0] = pk2(a[0], a[1]); w[1] = pk2(a[2], a[3]); w[2] = pk2(b[0], b[1]); w[3] = pk2(b[2], b[3]); *(u32x4*)dst = w; }
DI f32x4 ld_bf4(const bf16_t* src) { u32x2 w = *(const u32x2*)src; f32x4 r; r[0] = __uint_as_float(w[0] << 16); r[1] = __uint_as_float(w[0] & 0xffff0000u); r[2] = __uint_as_float(w[1] << 16); r[3] = __uint_as_float(w[1] & 0xffff0000u); return r; }
DI float wave_sum(float v) {
#pragma unroll
    for (int o = 32; o > 0; o >>= 1) v += __shfl_xor(v, o);
    return v;
}

DI void conv_T(const float* src, bf16_t* dst, int nb, int K, int N, long dst_bstride, const float* gain, int mode, float* tile, int vb, int vg) {
    const int t = threadIdx.x, tk = K / 64, tn = N / 64, per = tk * tn, total = nb * per;
    for (int it = vb; it < total; it += vg) {
        const int b = it / per, r = it % per, kt = r / tn, nt = r % tn;
        const float* s = src + (long)b * K * N + (long)kt * 64 * N + nt * 64;
#pragma unroll
        for (int i = 0; i < 4; ++i) {
            const int kk = (t >> 4) + 16 * i;
            float4 v = *(const float4*)(s + (long)kk * N + (t & 15) * 4);
            const float gs = gain ? gain[kt * 64 + kk] : 1.f;
            float* d = tile + kk * 65 + (t & 15) * 4;
            d[0] = v.x * gs; d[1] = v.y * gs; d[2] = v.z * gs; d[3] = v.w * gs;
        }
        __syncthreads();
        const int nl = t >> 2, kc = (t & 3) * 16, n = nt * 64 + nl;
        const int drow = (mode == 0) ? n : ((n >> 5) * 64 + (mode - 1) * 32 + (n & 31));
        unsigned w[8];
#pragma unroll
        for (int j = 0; j < 8; ++j) w[j] = pk2(tile[(kc + 2 * j) * 65 + nl], tile[(kc + 2 * j + 1) * 65 + nl]);
        bf16_t* d = dst + (long)b * dst_bstride + (long)drow * K + kt * 64 + kc;
        *(u32x4*)d = (u32x4){w[0], w[1], w[2], w[3]};
        *(u32x4*)(d + 8) = (u32x4){w[4], w[5], w[6], w[7]};
        __syncthreads();
    }
}

DI void conv_moe(const Params& P, int layer, float* tile, int vb, int vg) {
    bf16_t* w13 = (bf16_t*)(P.ws + OFF_WMOE);
    bf16_t* w2t = w13 + 16L * 2048 * 1024;
    const long lo = (long)layer * 16 * 1024 * 1024;
    conv_T(P.w1 + lo, w13, 16, 1024, 1024, 2048L * 1024, nullptr, 1, tile, vb, vg);
    conv_T(P.w3 + lo, w13, 16, 1024, 1024, 2048L * 1024, nullptr, 2, tile, vb, vg);
    conv_T(P.w2 + lo, w2t, 16, 1024, 1024, 1024L * 1024, nullptr, 0, tile, vb, vg);
}

struct GP { const bf16_t* A; long lda; const int* rowidx; int m0; const bf16_t* Bt; long ldb; int n0; int N; int K; int perm; };
constexpr int LDT = 72;
constexpr int STG = 384 * 64;
constexpr int RS_OFF = 3 * STG;
#define LAS3 __attribute__((address_space(3)))

DI int opaque_tid();
DI void gemm_main(const GP& g, f32x4 (&acc)[8][4], char* smem) {
    const int t = opaque_tid(), lane = t & 63, wid = t >> 6, wr = wid >> 1, wc = wid & 1, fr = lane & 15, fq = lane >> 4;
    unsigned ao[4], bo[2];
    const char* Ab = (const char*)g.A; const char* Bb = (const char*)g.Bt;
#pragma unroll
    for (int j = 0; j < 4; ++j) {
        const int row = (wid * 4 + j) * 16 + (lane >> 2), c = (lane & 3) ^ (((row >> 3) & 1) << 1);
        const long grow = g.rowidx ? (long)g.rowidx[g.m0 + row] : (long)(g.m0 + row);
        ao[j] = (unsigned)((grow * g.lda + c * 8) * 2);
    }
#pragma unroll
    for (int j = 0; j < 2; ++j) {
        const int row = (wid * 2 + j) * 16 + (lane >> 2), c = (lane & 3) ^ (((row >> 3) & 1) << 1);
        const int rho = row & 31, prow = g.perm ? ((row & ~31) | (8 * ((rho & 15) >> 2) + 4 * (rho >> 4) + (rho & 3))) : row;
        int brow = g.n0 + prow; brow = brow < g.N ? brow : g.N - 1;
        bo[j] = (unsigned)(((long)brow * g.ldb + c * 8) * 2);
    }
#define GLDS(kt_, st_) { \
        _Pragma("unroll") for (int j = 0; j < 4; ++j) __builtin_amdgcn_global_load_lds((const unsigned*)(Ab + (ao[j] + (unsigned)(kt_) * 64u)), (LAS3 unsigned*)(smem + (st_) * STG + (wid * 4 + j) * 1024), 16, 0, 0); \
        _Pragma("unroll") for (int j = 0; j < 2; ++j) __builtin_amdgcn_global_load_lds((const unsigned*)(Bb + (bo[j] + (unsigned)(kt_) * 64u)), (LAS3 unsigned*)(smem + (st_) * STG + 16384 + (wid * 2 + j) * 1024), 16, 0, 0); }
    const int nk = g.K / 32;
    const int pc8 = (fq ^ (((fr >> 3) & 1) << 1)) * 8;
    GLDS(0, 0)
    if (nk > 1) GLDS(1, 1)
    int sc = 0, sl = 2;
    for (int kt = 0; kt < nk; ++kt) {
        if (kt + 1 < nk) asm volatile("s_waitcnt vmcnt(6)" ::: "memory"); else asm volatile("s_waitcnt vmcnt(0)" ::: "memory");
        __builtin_amdgcn_s_barrier();
        asm volatile("" ::: "memory");
        if (kt + 2 < nk) GLDS(kt + 2, sl)
        const bf16_t* sA = (const bf16_t*)(smem + sc * STG); const bf16_t* sB = sA + 256 * 32;
        bf16x8 b[4];
#pragma unroll
        for (int n = 0; n < 4; ++n) b[n] = *(const bf16x8*)(sB + (wc * 64 + n * 16 + fr) * 32 + pc8);
#pragma unroll
        for (int mh = 0; mh < 4; ++mh) {
            bf16x8 a[2];
#pragma unroll
            for (int m = 0; m < 2; ++m) a[m] = *(const bf16x8*)(sA + (wr * 128 + (mh * 2 + m) * 16 + fr) * 32 + pc8);
#pragma unroll
            for (int m = 0; m < 2; ++m)
#pragma unroll
                for (int n = 0; n < 4; ++n) acc[mh * 2 + m][n] = MFMA16(b[n], a[m], acc[mh * 2 + m][n]);
        }
        sc = sc == 2 ? 0 : sc + 1; sl = sl == 2 ? 0 : sl + 1;
    }
    __syncthreads();
}
DI void zero_acc(f32x4 (&acc)[8][4]) {
#pragma unroll
    for (int m = 0; m < 8; ++m)
#pragma unroll
        for (int n = 0; n < 4; ++n) acc[m][n] = (f32x4){0.f, 0.f, 0.f, 0.f};
}
DI int opaque_tid() { int t = threadIdx.x; asm volatile("" : "+v"(t)); return t; }
#define TILE_IDS const int t = opaque_tid(), lane = t & 63, wid = t >> 6, wr = wid >> 1, wc = wid & 1, fr = lane & 15, fq = lane >> 4; (void)lane; (void)wr; (void)wc; (void)fr; (void)fq; (void)t;

DI bool xcd_next(int it, int nblk, int& blk, int& sl) {
    const int x = blockIdx.x & 7, s = blockIdx.x >> 3, ns = gridDim.x >> 3;
    const int q = it * ns + s;
    blk = (q >> 6) * 8 + x; sl = q & 63;
    return blk < nblk;
}

DI bool xcd_pop(const Params& P, int queue, int nblk, int& blk, int& sl, char* smem) {
    volatile int* slot = (volatile int*)(smem + LDS_BYTES - 64);
    const int x = blockIdx.x & 7;
    __syncthreads();
    if (threadIdx.x == 0) {
        unsigned* ctr = (unsigned*)(P.ws + OFF_MISC + M_QCTR) + (queue * 8 + x) * 16;
        slot[0] = (int)__hip_atomic_fetch_add(ctr, 1u, __ATOMIC_RELAXED, __HIP_MEMORY_SCOPE_AGENT);
    }
    __syncthreads();
    const int q = slot[0];
    blk = (q >> 6) * 8 + x; sl = q & 63;
    return blk < nblk;
}

DI void row_rms(const bf16_t* A, long lda, int m0, int K, float* rs) {
    const int t = threadIdx.x;
    const bf16_t* p = A + (long)(m0 + t) * lda;
    float ss = 0.f;
    for (int i = 0; i < K; i += 8) {
        const u32x4 v = *(const u32x4*)(p + i);
#pragma unroll
        for (int j = 0; j < 4; ++j) { float a = __uint_as_float(v[j] << 16), b = __uint_as_float(v[j] & 0xffff0000u); ss += a * a + b * b; }
    }
    rs[t] = rsqrtf(ss / (float)K + EPS);
}

DI void ph_win_even(const Params& P, char* smem) {
    bf16_t* h = (bf16_t*)(P.ws + OFF_A);
    const bf16_t* xb = (const bf16_t*)(P.ws + OFF_C);
    const bf16_t* Wt = (const bf16_t*)(P.ws + OFF_WS) + W_INE;
    for (int blk, sl; xcd_pop(P, 0, 32, blk, sl, smem); ) {
        TILE_IDS
        const int mt = (blk >> 1) * 8 + (sl >> 3), nt = (blk & 1) * 8 + (sl & 7);
        GP g{xb, 1024, nullptr, mt * 256, Wt, 1024, nt * 128, HE, 1024, 1};
        f32x4 acc[8][4]; zero_acc(acc);
        gemm_main(g, acc, smem);
#pragma unroll
        for (int m = 0; m < 8; ++m) {
            const long row = mt * 256 + wr * 128 + m * 16 + fr;
#pragma unroll
            for (int np = 0; np < 2; ++np) {
                const int col = nt * 128 + wc * 64 + np * 32 + fq * 8;
                if (col < HE) st_bf8(h + row * HE + col, acc[m][2 * np], acc[m][2 * np + 1]);
            }
        }
    }
}

DI void ph_uq(const Params& P, char* smem) {
    float* rs = (float*)(smem + RS_OFF);
    const bf16_t* h = (const bf16_t*)(P.ws + OFF_A);
    bf16_t* Qm = (bf16_t*)(P.ws + OFF_B);
    const bf16_t* Wt = (const bf16_t*)(P.ws + OFF_WS) + W_UQ;
    const float* ropeA = (const float*)(P.ws + OFF_MISC + M_ROPEA);
    const float qscale = 0.10206207261596577f * LOG2E;
    for (int it = 0, blk, sl; xcd_next(it, 12, blk, sl); ++it) {
        TILE_IDS
        const int mt = (blk / 3) * 32 + (sl >> 1), nt = (blk % 3) * 2 + (sl & 1);
        row_rms(h + H_CQ, HE, mt * 256, 256, rs);
        GP g{h + H_CQ, HE, nullptr, mt * 256, Wt, 256, nt * 128, 768, 256};
        f32x4 acc[8][4]; zero_acc(acc);
        gemm_main(g, acc, smem);
        const int tau0 = (nt * 128 + wc * 64) >> 4;
#pragma unroll
        for (int m = 0; m < 8; ++m) {
            const int rl = wr * 128 + m * 16 + fr; const long row = mt * 256 + rl;
            const float sc = rs[rl] * qscale; const int spos = (int)(row & (S - 1));
#pragma unroll
            for (int n = 0; n < 4; ++n) {
                const int r6 = (tau0 + n) % 6; const int col = nt * 128 + wc * 64 + n * 16 + fq * 4;
                if (r6 < 4) { st_bf4(Qm + row * 768 + col, acc[m][n] * sc); }
                else if (r6 == 4 && n < 3) {
                    f32x4 x1 = acc[m][n] * sc, x2 = acc[m][n + 1 < 4 ? n + 1 : n] * sc, o1, o2;
                    const float* cs = ropeA + spos * 32 + fq * 4;
#pragma unroll
                    for (int j = 0; j < 4; ++j) { const float c = cs[j], s = cs[16 + j]; o1[j] = x1[j] * c - x2[j] * s; o2[j] = x1[j] * s + x2[j] * c; }
                    st_bf4(Qm + row * 768 + col, o1); st_bf4(Qm + row * 768 + col + 16, o2);
                }
            }
        }
        __syncthreads();
    }
}
DI void ph_ukv(const Params& P, char* smem) {
    float* rs = (float*)(smem + RS_OFF);
    const bf16_t* h = (const bf16_t*)(P.ws + OFF_A);
    bf16_t* Kc = (bf16_t*)(P.ws + OFF_B + 48 * MiB); bf16_t* Vm = (bf16_t*)(P.ws + OFF_B + 96 * MiB);
    const bf16_t* Wt = (const bf16_t*)(P.ws + OFF_WS) + W_UKV;
    for (int it = 0, blk, sl; xcd_next(it, 16, blk, sl); ++it) {
        TILE_IDS
        const int mt = blk * 8 + (sl >> 3), nt = sl & 7;
        row_rms(h + H_CKV, HE, mt * 256, 128, rs);
        GP g{h + H_CKV, HE, nullptr, mt * 256, Wt, 128, nt * 128, 1024, 128, 1};
        f32x4 acc[8][4]; zero_acc(acc);
        gemm_main(g, acc, smem);
#pragma unroll
        for (int m = 0; m < 8; ++m) {
            const int rl = wr * 128 + m * 16 + fr; const long row = mt * 256 + rl; const float sc = rs[rl];
#pragma unroll
            for (int np = 0; np < 2; ++np) {
                const int c = np * 32 + fq * 8;
                if (wc == 0) st_bf8(Kc + row * 768 + nt * 96 + c, acc[m][2 * np] * sc, acc[m][2 * np + 1] * sc);
                else st_bf8(Vm + row * 512 + nt * 64 + c, acc[m][2 * np] * sc, acc[m][2 * np + 1] * sc);
            }
        }
        __syncthreads();
    }
}
DI void ph_kpe(const Params& P) {
    const bf16_t* h = (const bf16_t*)(P.ws + OFF_A);
    bf16_t* Kc = (bf16_t*)(P.ws + OFF_B + 48 * MiB);
    const float* ropeA = (const float*)(P.ws + OFF_MISC + M_ROPEA);
    for (long i = (long)blockIdx.x * NTHR + threadIdx.x; i < (long)T * 8; i += (long)gridDim.x * NTHR) {
        const long tok = i >> 3; const int hd = (int)(i & 7), spos = (int)(tok & (S - 1));
        const bf16_t* src = h + tok * HE + H_KPE; const float* cs = ropeA + spos * 32;
        bf16_t* dst = Kc + tok * 768 + hd * 96 + 64;
#pragma unroll
        for (int q4 = 0; q4 < 4; ++q4) {
            const f32x4 x1 = ld_bf4(src + q4 * 4), x2 = ld_bf4(src + 16 + q4 * 4), c = *(const f32x4*)(cs + q4 * 4), s = *(const f32x4*)(cs + 16 + q4 * 4);
            st_bf4(dst + q4 * 4, x1 * c - x2 * s); st_bf4(dst + 16 + q4 * 4, x1 * s + x2 * c);
        }
    }
}

DI float logsig(float z) { return fminf(z, 0.f) - __logf(1.f + __expf(-fabsf(z))); }
DI void gla_cum(const Params& P, int dir, const bf16_t* hrow0, int hh, char* smem) {
    float* s_cum = (float*)smem; float* s_lr = (float*)(smem + 16384); float* s_seg = (float*)(smem + 20480); float* s_tot = (float*)(smem + 21504);
    const int t = threadIdx.x;
    const int d = t & 63, lq = t >> 6;
    const float* gw = dir ? P.gw_b : P.gw_f; const float* gb = dir ? P.gb_b : P.gb_f;
    float w[16];
#pragma unroll
    for (int r = 0; r < 16; ++r) w[r] = gw[r * 256 + hh * 64 + d];
    const float bias = gb[hh * 64 + d];
    { const int l = t >> 2, r4 = (t & 3) * 4; f32x4 v = ld_bf4(hrow0 + (long)l * HE + H_LR + dir * 16 + r4);
      s_lr[l * 16 + r4] = v[0]; s_lr[l * 16 + r4 + 1] = v[1]; s_lr[l * 16 + r4 + 2] = v[2]; s_lr[l * 16 + r4 + 3] = v[3]; }
    __syncthreads();
    float la[16];
#pragma unroll
    for (int li = 0; li < 16; ++li) {
        const float* lr = s_lr + (lq * 16 + li) * 16; float z = bias;
#pragma unroll
        for (int r = 0; r < 16; ++r) z += lr[r] * w[r];
        la[li] = logsig(z) * 0.0625f;
    }
    if (dir == 0) {
#pragma unroll
        for (int li = 1; li < 16; ++li) la[li] += la[li - 1];
        s_seg[lq * 64 + d] = la[15];
    } else {
#pragma unroll
        for (int li = 14; li >= 0; --li) la[li] += la[li + 1];
        s_seg[lq * 64 + d] = la[0];
    }
    __syncthreads();
    float off = 0.f, tot = 0.f;
#pragma unroll
    for (int q = 0; q < 4; ++q) { const float sg = s_seg[q * 64 + d]; tot += sg; if (dir == 0 ? (q < lq) : (q > lq)) off += sg; }
#pragma unroll
    for (int li = 0; li < 16; ++li) s_cum[(lq * 16 + li) * 64 + d] = la[li] + off;
    if (lq == 0) s_tot[d] = tot;
    __syncthreads();
}
DI void gla_load_vt(const bf16_t* hrow0, int hh, char* smem) {
    bf16_t* Vt = (bf16_t*)(smem + 40960);
    const int t = threadIdx.x;
#pragma unroll
    for (int i = 0; i < 4; ++i) {
        const int c = t + 256 * i, l = c >> 4, e8 = (c & 15) * 8;
        const u32x4 v = *(const u32x4*)(hrow0 + (long)l * HE + H_GV + hh * 128 + e8);
#pragma unroll
        for (int j = 0; j < 4; ++j) { Vt[(e8 + 2 * j) * LDT + l] = (bf16_t)(v[j] & 0xffffu); Vt[(e8 + 2 * j + 1) * LDT + l] = (bf16_t)(v[j] >> 16); }
    }
}
DI void ph_gla1(const Params& P, char* smem) {
    TILE_IDS
    const bf16_t* h = (const bf16_t*)(P.ws + OFF_A);
    bf16_t* UT = (bf16_t*)(P.ws + OFF_C); float* DEC = (float*)(P.ws + OFF_MISC + M_DEC);
    float* s_cum = (float*)smem; float* s_tot = (float*)(smem + 21504);
    bf16_t* KDt = (bf16_t*)(smem + 22528); bf16_t* Vt = (bf16_t*)(smem + 40960);
    for (int unit = blockIdx.x; unit < NB * 4 * 32; unit += gridDim.x) {
        const int c = unit & 31, hh = (unit >> 5) & 3, b = unit >> 7;
        const bf16_t* hrow0 = h + ((long)b * S + c * 64) * HE;
        gla_load_vt(hrow0, hh, smem);
        for (int dir = 0; dir < 2; ++dir) {
            u32x2 kraw[4];
            { const int l = t >> 2, dc = (t & 3) * 16;
              const bf16_t* kp = hrow0 + (long)l * HE + H_GK + hh * 64 + dc;
#pragma unroll
              for (int q4 = 0; q4 < 4; ++q4) kraw[q4] = *(const u32x2*)(kp + q4 * 4); }
            gla_cum(P, dir, hrow0, hh, smem);
            { const int l = t >> 2, dc = (t & 3) * 16;
#pragma unroll
              for (int q4 = 0; q4 < 4; ++q4) {
                  const f32x4 kv = {__uint_as_float(kraw[q4][0] << 16), __uint_as_float(kraw[q4][0] & 0xffff0000u), __uint_as_float(kraw[q4][1] << 16), __uint_as_float(kraw[q4][1] & 0xffff0000u)};
#pragma unroll
                  for (int j = 0; j < 4; ++j) { const int d = dc + q4 * 4 + j; KDt[d * LDT + l] = f2bf(kv[j] * __expf(s_tot[d] - s_cum[l * 64 + d])); } } }
            __syncthreads();
            const long u = ((long)(b * 4 + hh) * 2 + dir) * 32 + c;
            if (t < 64) DEC[u * 64 + t] = __expf(s_tot[t]);
            f32x4 acc[2][4];
#pragma unroll
            for (int e = 0; e < 2; ++e)
#pragma unroll
                for (int dt = 0; dt < 4; ++dt) acc[e][dt] = (f32x4){0.f, 0.f, 0.f, 0.f};
#pragma unroll
            for (int ks = 0; ks < 2; ++ks) {
                bf16x8 vf[2], kf[4];
#pragma unroll
                for (int e = 0; e < 2; ++e) vf[e] = *(const bf16x8*)(Vt + ((wid * 2 + e) * 16 + fr) * LDT + ks * 32 + fq * 8);
#pragma unroll
                for (int dt = 0; dt < 4; ++dt) kf[dt] = *(const bf16x8*)(KDt + (dt * 16 + fr) * LDT + ks * 32 + fq * 8);
#pragma unroll
                for (int e = 0; e < 2; ++e)
#pragma unroll
                    for (int dt = 0; dt < 4; ++dt) acc[e][dt] = MFMA16(kf[dt], vf[e], acc[e][dt]);
            }
            bf16_t* ut = UT + u * 8192;
#pragma unroll
            for (int e = 0; e < 2; ++e)
#pragma unroll
                for (int dt = 0; dt < 4; ++dt) st_bf4(ut + ((wid * 2 + e) * 16 + fr) * 64 + dt * 16 + fq * 4, acc[e][dt]);
            __syncthreads();
        }
    }
}
DI void ph_gla2(const Params& P) {
    bf16_t* UT = (bf16_t*)(P.ws + OFF_C); const float* DEC = (const float*)(P.ws + OFF_MISC + M_DEC);
    for (int item = blockIdx.x; item < 128 * 4; item += gridDim.x) {
        const int seq = item >> 2, ec = (item & 3) * 256 + threadIdx.x, dir = seq & 1;
        const int d0 = (ec * 8) & 63;
        float st[8];
#pragma unroll
        for (int j = 0; j < 8; ++j) st[j] = 0.f;
#pragma unroll 4
        for (int i = 0; i < 32; ++i) {
            const int c = dir ? 31 - i : i; const long u = (long)seq * 32 + c;
            u32x4* pp = (u32x4*)(UT + u * 8192 + ec * 8);
            const u32x4 v = *pp; const f32x4 da = *(const f32x4*)(DEC + u * 64 + d0), db = *(const f32x4*)(DEC + u * 64 + d0 + 4);
            u32x4 o; o[0] = pk2(st[0], st[1]); o[1] = pk2(st[2], st[3]); o[2] = pk2(st[4], st[5]); o[3] = pk2(st[6], st[7]);
            *pp = o;
#pragma unroll
            for (int j = 0; j < 4; ++j) { const float d0_ = j < 2 ? da[2 * (j & 1)] : db[2 * (j & 1)], d1_ = j < 2 ? da[2 * (j & 1) + 1] : db[2 * (j & 1) + 1];
                st[2 * j] = d0_ * st[2 * j] + __uint_as_float(v[j] << 16); st[2 * j + 1] = d1_ * st[2 * j + 1] + __uint_as_float(v[j] & 0xffff0000u); }
        }
    }
}
DI void ph_gla3(const Params& P, char* smem) {
    TILE_IDS
    const bf16_t* h = (const bf16_t*)(P.ws + OFF_A);
    const bf16_t* UT = (const bf16_t*)(P.ws + OFF_C);
    bf16_t* mix = (bf16_t*)(P.ws + OFF_D);
    float* s_cum = (float*)smem;
    bf16_t* QG = (bf16_t*)(smem + 22528); bf16_t* KG = (bf16_t*)(smem + 31744); bf16_t* Vt = (bf16_t*)(smem + 40960);
    for (int unit = blockIdx.x; unit < NB * 4 * 32; unit += gridDim.x) {
        const int c = unit & 31, hh = (unit >> 5) & 3, b = unit >> 7;
        const long tok0 = (long)b * S + c * 64;
        const bf16_t* hrow0 = h + tok0 * HE;
        gla_load_vt(hrow0, hh, smem);
        f32x4 oacc[8];
#pragma unroll
        for (int e = 0; e < 8; ++e) oacc[e] = (f32x4){0.f, 0.f, 0.f, 0.f};
        for (int dir = 0; dir < 2; ++dir) {
            u32x2 qraw[4], kraw[4]; bf16x8 sfr[8][2];
            { const int l = t >> 2, dc = (t & 3) * 16;
              const bf16_t* qp = hrow0 + (long)l * HE + H_GQ + hh * 64 + dc; const bf16_t* kp = hrow0 + (long)l * HE + H_GK + hh * 64 + dc;
#pragma unroll
              for (int q4 = 0; q4 < 4; ++q4) { qraw[q4] = *(const u32x2*)(qp + q4 * 4); kraw[q4] = *(const u32x2*)(kp + q4 * 4); } }
            { const bf16_t* sp0 = UT + (((long)(b * 4 + hh) * 2 + dir) * 32 + c) * 8192;
#pragma unroll
              for (int e = 0; e < 8; ++e)
#pragma unroll
                  for (int ks = 0; ks < 2; ++ks) sfr[e][ks] = *(const bf16x8*)(sp0 + (e * 16 + fr) * 64 + ks * 32 + fq * 8); }
            gla_cum(P, dir, hrow0, hh, smem);
            { const int l = t >> 2, dc = (t & 3) * 16;
#pragma unroll
              for (int q4 = 0; q4 < 4; ++q4) {
                  const f32x4 qv = {__uint_as_float(qraw[q4][0] << 16), __uint_as_float(qraw[q4][0] & 0xffff0000u), __uint_as_float(qraw[q4][1] << 16), __uint_as_float(qraw[q4][1] & 0xffff0000u)};
                  const f32x4 kv = {__uint_as_float(kraw[q4][0] << 16), __uint_as_float(kraw[q4][0] & 0xffff0000u), __uint_as_float(kraw[q4][1] << 16), __uint_as_float(kraw[q4][1] & 0xffff0000u)};
                  f32x4 qo, ko;
#pragma unroll
                  for (int j = 0; j < 4; ++j) { const float cm = s_cum[l * 64 + dc + q4 * 4 + j]; qo[j] = qv[j] * 0.125f * __expf(cm); ko[j] = kv[j] * __expf(-cm); }
                  st_bf4(QG + l * LDT + dc + q4 * 4, qo); st_bf4(KG + l * LDT + dc + q4 * 4, ko); } }
            __syncthreads();
            f32x4 att[4];
#pragma unroll
            for (int mt = 0; mt < 4; ++mt) att[mt] = (f32x4){0.f, 0.f, 0.f, 0.f};
            bf16x8 qf[2];
#pragma unroll
            for (int ks = 0; ks < 2; ++ks) qf[ks] = *(const bf16x8*)(QG + (wid * 16 + fr) * LDT + ks * 32 + fq * 8);
#pragma unroll
            for (int ks = 0; ks < 2; ++ks)
#pragma unroll
                for (int mt = 0; mt < 4; ++mt) { bf16x8 kf = *(const bf16x8*)(KG + (mt * 16 + fr) * LDT + ks * 32 + fq * 8); att[mt] = MFMA16(kf, qf[ks], att[mt]); }
            const int lrow = wid * 16 + fr;
#pragma unroll
            for (int mt = 0; mt < 4; ++mt)
#pragma unroll
                for (int j = 0; j < 4; ++j) { const int mm = mt * 16 + fq * 4 + j; const bool keep = dir == 0 ? (mm <= lrow) : (mm >= lrow); if (!keep) att[mt][j] = 0.f; }
            bf16x8 pb[2];
#pragma unroll
            for (int k2 = 0; k2 < 2; ++k2) { u32x4 w; w[0] = pk2(att[2 * k2][0], att[2 * k2][1]); w[1] = pk2(att[2 * k2][2], att[2 * k2][3]); w[2] = pk2(att[2 * k2 + 1][0], att[2 * k2 + 1][1]); w[3] = pk2(att[2 * k2 + 1][2], att[2 * k2 + 1][3]); pb[k2] = __builtin_bit_cast(bf16x8, w); }
#pragma unroll
            for (int e = 0; e < 8; ++e) {
#pragma unroll
                for (int k2 = 0; k2 < 2; ++k2) {
                    const s16x4 lo = *(const s16x4*)(Vt + (e * 16 + fr) * LDT + k2 * 32 + fq * 4), hi = *(const s16x4*)(Vt + (e * 16 + fr) * LDT + k2 * 32 + 16 + fq * 4);
                    const bf16x8 vf = __builtin_shufflevector(lo, hi, 0, 1, 2, 3, 4, 5, 6, 7);
                    oacc[e] = MFMA16(vf, pb[k2], oacc[e]);
                }
#pragma unroll
                for (int ks = 0; ks < 2; ++ks) oacc[e] = MFMA16(sfr[e][ks], qf[ks], oacc[e]);
            }
            __syncthreads();
        }
        float ss = 0.f;
#pragma unroll
        for (int e = 0; e < 8; ++e)
#pragma unroll
            for (int j = 0; j < 4; ++j) ss += oacc[e][j] * oacc[e][j];
        ss += __shfl_xor(ss, 16); ss += __shfl_xor(ss, 32);
        const float rinv = rsqrtf(ss * (1.f / 128.f) + EPS);
        const long tok = tok0 + wid * 16 + fr;
#pragma unroll
        for (int e = 0; e < 8; ++e) {
            const int ee = e * 16 + fq * 4;
            const f32x4 gr = ld_bf4(h + tok * HE + H_GR + hh * 128 + ee); const f32x4 gn = *(const f32x4*)(P.gla_norm + ee); f32x4 o;
#pragma unroll
            for (int j = 0; j < 4; ++j) { const float g = gr[j]; o[j] = oacc[e][j] * rinv * gn[j] * (g / (1.f + __expf(-g))); }
            st_bf4(mix + tok * 1024 + 512 + hh * 128 + ee, o);
        }
    }
}

template <int DQK>
DI void attn_unit(const bf16_t* Q, int q_ss, const bf16_t* K, int k_ss, const bf16_t* V, int v_ss, bf16_t* O, char* smem) {
    TILE_IDS
    constexpr int KS = DQK / 32, CPR = DQK / 8, ROWB = DQK * 2, KBYTES = 64 * ROWB, NKP = KBYTES / 1024 / 4  , ASTG = KBYTES + 8192;
    constexpr int QT = DQK == 64 ? 4 : 2;
    bf16x8 qf[QT][KS];
#pragma unroll
    for (int qt = 0; qt < QT; ++qt)
#pragma unroll
        for (int ks = 0; ks < KS; ++ks) qf[qt][ks] = *(const bf16x8*)(Q + (long)(wid * (QT * 16) + qt * 16 + fr) * q_ss + ks * 32 + fq * 8);
    f32x4 oacc[4][QT];
#pragma unroll
    for (int dt = 0; dt < 4; ++dt)
#pragma unroll
        for (int qt = 0; qt < QT; ++qt) oacc[dt][qt] = (f32x4){0.f, 0.f, 0.f, 0.f};
    float mrun[QT], lrun[QT];
#pragma unroll
    for (int qt = 0; qt < QT; ++qt) { mrun[qt] = 0.f; lrun[qt] = 0.f; }
    unsigned ko[NKP], vo[2];
#pragma unroll
    for (int i = 0; i < NKP; ++i) {
        const int q = (wid * NKP + i) * 64 + lane, row = q / CPR, pc = q % CPR;
        const int cc = DQK == 96 ? ((pc & ~3) | ((pc & 3) ^ (((row >> 3) & 1) << 1))) : (pc ^ ((row >> 1) & 7));
        ko[i] = (unsigned)((row * k_ss + cc * 8) * 2);
    }
#pragma unroll
    for (int i = 0; i < 2; ++i) {
        const int q = (wid * 2 + i) * 64 + lane, row = q >> 3, pc = q & 7, cc = pc ^ (((row >> 1) & 3) << 1);
        vo[i] = (unsigned)((row * v_ss + cc * 8) * 2);
    }
    const char* Kb = (const char*)K; const char* Vb = (const char*)V;
    const unsigned kstep = (unsigned)(64 * k_ss * 2), vstep = (unsigned)(64 * v_ss * 2);
#define ALDS(kt_, st_) { \
        _Pragma("unroll") for (int i = 0; i < NKP; ++i) __builtin_amdgcn_global_load_lds((const unsigned*)(Kb + (ko[i] + (unsigned)(kt_) * kstep)), (LAS3 unsigned*)(smem + (st_) * ASTG + (wid * NKP + i) * 1024), 16, 0, 0); \
        _Pragma("unroll") for (int i = 0; i < 2; ++i) __builtin_amdgcn_global_load_lds((const unsigned*)(Vb + (vo[i] + (unsigned)(kt_) * vstep)), (LAS3 unsigned*)(smem + (st_) * ASTG + KBYTES + (wid * 2 + i) * 1024), 16, 0, 0); }
    const int kpc96 = fq ^ (((fr >> 3) & 1) << 1), ksw64 = (fr >> 1) & 7;
    const int vq = fr >> 2, vp = fr & 3, vsw = ((2 * fq + (vq >> 1)) & 3) << 1;
    ALDS(0, 0)
    ALDS(1, 1)
    int sc = 0, sl = 2;
    for (int kt = 0; kt < S / 64; ++kt) {
        if (kt + 1 < S / 64) { if (NKP == 3) asm volatile("s_waitcnt vmcnt(5)" ::: "memory"); else asm volatile("s_waitcnt vmcnt(4)" ::: "memory"); }
        else asm volatile("s_waitcnt vmcnt(0)" ::: "memory");
        __builtin_amdgcn_s_barrier();
        asm volatile("" ::: "memory");
        if (kt + 2 < S / 64) ALDS(kt + 2, sl)
        const char* Ks = smem + sc * ASTG; const char* Vs = Ks + KBYTES;
        f32x4 st[4][QT];
#pragma unroll
        for (int mt = 0; mt < 4; ++mt)
#pragma unroll
            for (int qt = 0; qt < QT; ++qt) { const float nm = -mrun[qt]; st[mt][qt] = (f32x4){nm, nm, nm, nm}; }
#pragma unroll
        for (int ks = 0; ks < KS; ++ks)
#pragma unroll
            for (int mt = 0; mt < 4; ++mt) {
                const int pc = DQK == 96 ? (4 * ks + kpc96) : ((4 * ks + fq) ^ ksw64);
                const bf16x8 kf = *(const bf16x8*)(Ks + (mt * 16 + fr) * ROWB + pc * 16);
#pragma unroll
                for (int qt = 0; qt < QT; ++qt) st[mt][qt] = MFMA16(kf, qf[qt][ks], st[mt][qt]);
            }
        bf16x8 pb[QT][2];
#pragma unroll
        for (int qt = 0; qt < QT; ++qt) {
            float mx = st[0][qt][0];
#pragma unroll
            for (int mt = 0; mt < 4; ++mt)
#pragma unroll
                for (int j = 0; j < 4; ++j) mx = fmaxf(mx, st[mt][qt][j]);
            mx = fmaxf(mx, __shfl_xor(mx, 16)); mx = fmaxf(mx, __shfl_xor(mx, 32));
            if (kt == 0) {
                mrun[qt] = mx;
#pragma unroll
                for (int mt = 0; mt < 4; ++mt) st[mt][qt] = st[mt][qt] - mx;
            } else {
                const bool need = mx > 8.f;
                if (__any(need)) {
                    const float delta = need ? mx : 0.f, alpha = __builtin_amdgcn_exp2f(-delta);
                    mrun[qt] += delta; lrun[qt] *= alpha;
#pragma unroll
                    for (int mt = 0; mt < 4; ++mt) st[mt][qt] = st[mt][qt] - delta;
#pragma unroll
                    for (int dt = 0; dt < 4; ++dt) oacc[dt][qt] *= alpha;
                }
            }
            float rsum = 0.f;
#pragma unroll
            for (int mt = 0; mt < 4; ++mt)
#pragma unroll
                for (int j = 0; j < 4; ++j) { const float pv = __builtin_amdgcn_exp2f(st[mt][qt][j]); st[mt][qt][j] = pv; rsum += pv; }
            lrun[qt] += rsum;
#pragma unroll
            for (int k2 = 0; k2 < 2; ++k2) { u32x4 w; w[0] = pk2(st[2 * k2][qt][0], st[2 * k2][qt][1]); w[1] = pk2(st[2 * k2][qt][2], st[2 * k2][qt][3]); w[2] = pk2(st[2 * k2 + 1][qt][0], st[2 * k2 + 1][qt][1]); w[3] = pk2(st[2 * k2 + 1][qt][2], st[2 * k2 + 1][qt][3]); pb[qt][k2] = __builtin_bit_cast(bf16x8, w); }
        }
#pragma unroll
        for (int dt = 0; dt < 4; ++dt)
#pragma unroll
            for (int k2 = 0; k2 < 2; ++k2) {
                const int pcv = (2 * dt + (vp >> 1)) ^ vsw;
                const char* base = Vs + (k2 * 32 + 4 * fq + vq) * 128 + pcv * 16 + (vp & 1) * 8;
                const s16x4 lo = __builtin_amdgcn_ds_read_tr16_b64_v4i16((LAS3 s16x4*)(base));
                const s16x4 hi = __builtin_amdgcn_ds_read_tr16_b64_v4i16((LAS3 s16x4*)(base + 16 * 128));
                const bf16x8 vf = __builtin_shufflevector(lo, hi, 0, 1, 2, 3, 4, 5, 6, 7);
#pragma unroll
                for (int qt = 0; qt < QT; ++qt) oacc[dt][qt] = MFMA16(vf, pb[qt][k2], oacc[dt][qt]);
            }
        sc = sc == 2 ? 0 : sc + 1; sl = sl == 2 ? 0 : sl + 1;
    }
    __syncthreads();
#pragma unroll
    for (int qt = 0; qt < QT; ++qt) {
        float l = lrun[qt]; l += __shfl_xor(l, 16); l += __shfl_xor(l, 32);
        const float inv = 1.f / l;
#pragma unroll
        for (int dt = 0; dt < 4; ++dt) st_bf4(O + (long)(wid * (QT * 16) + qt * 16 + fr) * 1024 + dt * 16 + fq * 4, oacc[dt][qt] * inv);
    }
}
DI void ph_attn_mla(const Params& P, char* smem) {
    const bf16_t* Qm = (const bf16_t*)(P.ws + OFF_B); const bf16_t* Kc = (const bf16_t*)(P.ws + OFF_B + 48 * MiB); const bf16_t* Vm = (const bf16_t*)(P.ws + OFF_B + 96 * MiB);
    bf16_t* mix = (bf16_t*)(P.ws + OFF_D);
    for (int blk, sl; xcd_pop(P, 8, 32, blk, sl, smem); ) {
        const int pair = blk * 4 + (sl >> 4), qb = sl & 15, hd = pair & 7, b = pair >> 3;
        const long tq = (long)b * S + qb * 128, tk = (long)b * S;
        attn_unit<96>(Qm + tq * 768 + hd * 96, 768, Kc + tk * 768 + hd * 96, 768, Vm + tk * 512 + hd * 64, 512, mix + tq * 1024 + hd * 64, smem);
    }
}
DI void ph_attn_gqa(const Params& P, char* smem) {
    const bf16_t* qkv = (const bf16_t*)(P.ws + OFF_A);
    bf16_t* mix = (bf16_t*)(P.ws + OFF_D);
    for (int blk, sl; xcd_pop(P, 9, 32, blk, sl, smem); ) {
        const int grp = blk * 2 + (sl >> 5), qb = sl & 7, b = grp >> 2, kv = grp & 3, hd = kv * 4 + ((sl >> 3) & 3);
        const long tq = (long)b * S + qb * 256, tk = (long)b * S;
        attn_unit<64>(qkv + tq * 1536 + hd * 64, 1536, qkv + tk * 1536 + 1024 + kv * 64, 1536, qkv + tk * 1536 + 1280 + kv * 64, 1536, mix + tq * 1024 + hd * 64, smem);
    }
}

DI void ph_wo(const Params& P, int layer, char* smem) {
    const bf16_t* mix = (const bf16_t*)(P.ws + OFF_D);
    const bf16_t* x2h = (const bf16_t*)(P.ws + OFF_B);
    float* pre1 = (float*)(P.ws + OFF_A);
    const bf16_t* Wt = (const bf16_t*)(P.ws + OFF_WS) + W_O + (long)layer * 1048576;
    for (int blk, sl; xcd_pop(P, 1 + layer, 16, blk, sl, smem); ) {
        TILE_IDS
        const int mt = blk * 8 + (sl >> 3), nt = sl & 7;
        GP g{mix, 1024, nullptr, mt * 256, Wt, 1024, nt * 128, 1024, 1024, 1};
        f32x4 acc[8][4]; zero_acc(acc);
        gemm_main(g, acc, smem);
#pragma unroll
        for (int m = 0; m < 8; ++m) {
            const long row = mt * 256 + wr * 128 + m * 16 + fr;
#pragma unroll
            for (int np = 0; np < 2; ++np) {
                const int col = nt * 128 + wc * 64 + np * 32 + fq * 8;
                f32x4 xv0, xv1;
                if (layer == 0) { xv0 = *(const f32x4*)(P.x + row * 1024 + col); xv1 = *(const f32x4*)(P.x + row * 1024 + col + 4); }
                else { const u32x4 w = *(const u32x4*)(x2h + row * 1024 + col);
                       xv0 = (f32x4){__uint_as_float(w[0] << 16), __uint_as_float(w[0] & 0xffff0000u), __uint_as_float(w[1] << 16), __uint_as_float(w[1] & 0xffff0000u)};
                       xv1 = (f32x4){__uint_as_float(w[2] << 16), __uint_as_float(w[2] & 0xffff0000u), __uint_as_float(w[3] << 16), __uint_as_float(w[3] & 0xffff0000u)}; }
                *(f32x4*)(pre1 + row * 1024 + col) = xv0 * ALPHA + acc[m][2 * np];
                *(f32x4*)(pre1 + row * 1024 + col + 4) = xv1 * ALPHA + acc[m][2 * np + 1];
            }
        }
    }
}

DI void ph_ln1_router(const Params& P, int layer, char* smem) {
    const int t = threadIdx.x, lane = t & 63, wid = t >> 6;
    float* rwT = (float*)smem;
    const float* rw = P.router_w + (long)layer * 1024 * 16;
    for (int i = t; i < 16384; i += NTHR) { const int k = i >> 4, e = i & 15; rwT[e * 1024 + k] = rw[i]; }
    __syncthreads();
    const float* pre1 = (const float*)(P.ws + OFF_A); bf16_t* x1h = (bf16_t*)(P.ws + OFF_B); float* aff = (float*)(P.ws + OFF_MISC + M_AFF);
    const float* g = P.ln1_g + layer * 1024; const float* bb = P.ln1_b + layer * 1024;
    for (long row = (long)blockIdx.x * 4 + wid; row < T; row += (long)gridDim.x * 4) {
        f32x4 v[4]; float s = 0.f;
#pragma unroll
        for (int i = 0; i < 4; ++i) { v[i] = *(const f32x4*)(pre1 + row * 1024 + i * 256 + lane * 4); s += (v[i][0] + v[i][1]) + (v[i][2] + v[i][3]); }
        const float mean = wave_sum(s) * (1.f / 1024.f);
        float q = 0.f;
#pragma unroll
        for (int i = 0; i < 4; ++i) { v[i] = v[i] - mean; q += (v[i][0] * v[i][0] + v[i][1] * v[i][1]) + (v[i][2] * v[i][2] + v[i][3] * v[i][3]); }
        const float rstd = rsqrtf(wave_sum(q) * (1.f / 1024.f) + EPS);
#pragma unroll
        for (int i = 0; i < 4; ++i) { const f32x4 gg = *(const f32x4*)(g + i * 256 + lane * 4), bv = *(const f32x4*)(bb + i * 256 + lane * 4); v[i] = v[i] * rstd * gg + bv; const long o_ = row * 1024 + i * 256 + lane * 4; st_bf4(x1h + o_, v[i]); }
        float p[16];
#pragma unroll
        for (int e = 0; e < 16; ++e) {
            float a = 0.f;
#pragma unroll
            for (int i = 0; i < 4; ++i) { const f32x4 w = *(const f32x4*)(rwT + e * 1024 + i * 256 + lane * 4); a += (v[i][0] * w[0] + v[i][1] * w[1]) + (v[i][2] * w[2] + v[i][3] * w[3]); }
            p[e] = a;
            if ((e & 3) == 3) __builtin_amdgcn_sched_barrier(0);
        }
        const bool h5 = lane & 32, h4 = lane & 16, h3 = lane & 8, h2 = lane & 4;
        float r8[8], r4[4], r2[2];
#pragma unroll
        for (int e = 0; e < 8; ++e) { const float keep = h5 ? p[e + 8] : p[e], send = h5 ? p[e] : p[e + 8]; r8[e] = keep + __shfl_xor(send, 32); }
#pragma unroll
        for (int e = 0; e < 4; ++e) { const float keep = h4 ? r8[e + 4] : r8[e], send = h4 ? r8[e] : r8[e + 4]; r4[e] = keep + __shfl_xor(send, 16); }
#pragma unroll
        for (int e = 0; e < 2; ++e) { const float keep = h3 ? r4[e + 2] : r4[e], send = h3 ? r4[e] : r4[e + 2]; r2[e] = keep + __shfl_xor(send, 8); }
        float mylg; { const float keep = h2 ? r2[1] : r2[0], send = h2 ? r2[0] : r2[1]; mylg = keep + __shfl_xor(send, 4); }
        mylg += __shfl_xor(mylg, 2); mylg += __shfl_xor(mylg, 1);
        float mx = mylg;
        mx = fmaxf(mx, __shfl_xor(mx, 32)); mx = fmaxf(mx, __shfl_xor(mx, 16)); mx = fmaxf(mx, __shfl_xor(mx, 8)); mx = fmaxf(mx, __shfl_xor(mx, 4));
        const float ex = expf(mylg - mx);
        float den = ex;
        den += __shfl_xor(den, 32); den += __shfl_xor(den, 16); den += __shfl_xor(den, 8); den += __shfl_xor(den, 4);
        const float mine = ex / den;
        const int myE = (h5 ? 8 : 0) + (h4 ? 4 : 0) + (h3 ? 2 : 0) + (h2 ? 1 : 0);
        if ((lane & 3) == 0) { const long b = row >> 11, sp = row & (S - 1); aff[(b * 16 + myE) * S + sp] = mine; }
    }
    __syncthreads();
}

DI void ph_topk(const Params& P, char* smem) {
    const int t = threadIdx.x;
    unsigned long long* key = (unsigned long long*)smem;
    const float* aff = (const float*)(P.ws + OFF_MISC + M_AFF);
    int* seli = (int*)(P.ws + OFF_MISC + M_SELI); float* selg = (float*)(P.ws + OFF_MISC + M_SELG); int* inv = (int*)(P.ws + OFF_MISC + M_INV);
    for (int unit = blockIdx.x; unit < NB * 16; unit += gridDim.x) {
        const int b = unit >> 4, e = unit & 15;
        for (int i = t; i < S; i += NTHR) key[i] = ((unsigned long long)__float_as_uint(aff[(long)unit * S + i]) << 32) | (unsigned)(S - 1 - i);
        __syncthreads();
        const int qbase = (t >> 6) * 256 + (t & 63);
        for (int k = 2; k <= S; k <<= 1)
            for (int j = k >> 1; j > 0; j >>= 1) {
#pragma unroll
                for (int r = 0; r < 4; ++r) {
                    const int q = qbase + 64 * r;
                    const int i = ((q & ~(j - 1)) << 1) | (q & (j - 1)), l = i | j;
                    const unsigned long long a = key[i], c = key[l];
                    const bool desc = (i & k) == 0;
                    if (desc ? (a < c) : (a > c)) { key[i] = c; key[l] = a; }
                }
                if (j >= 512 || (j == 1 && k >= 512)) __syncthreads();
                else asm volatile("s_waitcnt lgkmcnt(0)" ::: "memory");
            }
        __syncthreads();
        for (int i = t; i < S; i += NTHR) {
            const unsigned long long kk = key[i]; const int idx = S - 1 - (int)(unsigned)(kk & 0xffffffffu);
            if (i < 256) { seli[unit * 256 + i] = b * S + idx; selg[unit * 256 + i] = __uint_as_float((unsigned)(kk >> 32)); }
            inv[((long)b * S + idx) * 16 + e] = i < 256 ? i : -1;
        }
        __syncthreads();
    }
}
DI void ph_ple(const Params& P, int layer, char* smem) {
    const bf16_t* x1h = (const bf16_t*)(P.ws + OFF_B); const bf16_t* pb = (const bf16_t*)(P.ws + OFF_P) + (long)layer * T * 256;
    bf16_t* ple = (bf16_t*)(P.ws + OFF_A);
    const bf16_t* Wg = (const bf16_t*)(P.ws + OFF_WS) + W_PG + (long)layer * 1048576;
    const bf16_t* Wp = (const bf16_t*)(P.ws + OFF_WS) + W_PW + (long)layer * 262144;
    const float* bg = P.pg_b + layer * 1024;
    for (int blk, sl; xcd_pop(P, 10 + layer, 16, blk, sl, smem); ) {
        TILE_IDS
        const int mt = blk * 8 + (sl >> 3), nt = sl & 7;
        f32x4 acc[8][4]; zero_acc(acc);
        { GP g{pb, 256, nullptr, mt * 256, Wp, 256, nt * 128, 1024, 256, 1}; gemm_main(g, acc, smem); }
#pragma unroll
        for (int m = 0; m < 8; ++m)
#pragma unroll
            for (int np = 0; np < 2; ++np) st_bf8(ple + (long)(mt * 256 + wr * 128 + m * 16 + fr) * 1024 + nt * 128 + wc * 64 + np * 32 + fq * 8, acc[m][2 * np], acc[m][2 * np + 1]);
        zero_acc(acc);
        { GP g{x1h, 1024, nullptr, mt * 256, Wg, 1024, nt * 128, 1024, 1024, 1}; gemm_main(g, acc, smem); }
#pragma unroll
        for (int m = 0; m < 8; ++m) {
            const long row = mt * 256 + wr * 128 + m * 16 + fr;
#pragma unroll
            for (int np = 0; np < 2; ++np) {
                const int col = nt * 128 + wc * 64 + np * 32 + fq * 8;
                const u32x4 lw = *(const u32x4*)(ple + row * 1024 + col);
                f32x4 o[2];
#pragma unroll
                for (int h2 = 0; h2 < 2; ++h2) {
                    const f32x4 bv = *(const f32x4*)(bg + col + 4 * h2);
                    const f32x4 l4 = {__uint_as_float(lw[2 * h2] << 16), __uint_as_float(lw[2 * h2] & 0xffff0000u), __uint_as_float(lw[2 * h2 + 1] << 16), __uint_as_float(lw[2 * h2 + 1] & 0xffff0000u)};
#pragma unroll
                    for (int j = 0; j < 4; ++j) o[h2][j] = l4[j] / (1.f + __expf(-(acc[m][2 * np + h2][j] + bv[j])));
                }
                st_bf8(ple + row * 1024 + col, o[0], o[1]);
            }
        }
    }
}
DI void ph_moe1(const Params& P, char* smem, int layer_) {
    const bf16_t* x1h = (const bf16_t*)(P.ws + OFF_B); const int* seli = (const int*)(P.ws + OFF_MISC + M_SELI);
    const bf16_t* w13 = (const bf16_t*)(P.ws + OFF_WMOE);
    bf16_t* hid = (bf16_t*)(P.ws + OFF_C);
    for (int blk, sl; xcd_pop(P, 3 + layer_, 64, blk, sl, smem); ) {
        TILE_IDS
        const int nt = sl & 15, b = (blk & 3) * 4 + (sl >> 4), e = blk >> 2, grp = b * 16 + e;
        GP g{x1h, 1024, seli + grp * 256, 0, w13 + (long)e * 2048 * 1024, 1024, nt * 128, 2048, 1024, 1};
        f32x4 acc[8][4]; zero_acc(acc);
        gemm_main(g, acc, smem);
#pragma unroll
        for (int m = 0; m < 8; ++m) {
            const long row = (long)grp * 256 + wr * 128 + m * 16 + fr;
            { f32x4 o[2];
#pragma unroll
              for (int n = 0; n < 2; ++n)
#pragma unroll
                  for (int j = 0; j < 4; ++j) { const float a = acc[m][n][j]; o[n][j] = a / (1.f + __expf(-a)) * acc[m][n + 2][j]; }
              st_bf8(hid + row * 1024 + nt * 64 + wc * 32 + fq * 8, o[0], o[1]); }
        }
    }
}
DI void ph_moe2(const Params& P, char* smem, int layer_) {
    const bf16_t* hid = (const bf16_t*)(P.ws + OFF_C);
    const bf16_t* w2t = (const bf16_t*)(P.ws + OFF_WMOE) + 16L * 2048 * 1024;
    bf16_t* ye = (bf16_t*)(P.ws + OFF_A + 64 * MiB);
    for (int blk, sl; xcd_pop(P, 5 + layer_, 32, blk, sl, smem); ) {
        TILE_IDS
        const int nt = sl & 7, b = (blk & 1) * 8 + (sl >> 3), e = blk >> 1, grp = b * 16 + e;
        GP g{hid + (long)grp * 256 * 1024, 1024, nullptr, 0, w2t + (long)e * 1024 * 1024, 1024, nt * 128, 1024, 1024, 1};
        f32x4 acc[8][4]; zero_acc(acc);
        gemm_main(g, acc, smem);
#pragma unroll
        for (int m = 0; m < 8; ++m) {
            const long row = (long)grp * 256 + wr * 128 + m * 16 + fr;
#pragma unroll
            for (int np = 0; np < 2; ++np) st_bf8(ye + row * 1024 + nt * 128 + wc * 64 + np * 32 + fq * 8, acc[m][2 * np], acc[m][2 * np + 1]);
        }
    }
}
DI void ph_ln2(const Params& P, int layer) {
    const int t = opaque_tid(), lane = t & 63, wid = t >> 6;
    bf16_t* x1h = (bf16_t*)(P.ws + OFF_B); const bf16_t* ple = (const bf16_t*)(P.ws + OFF_A); const bf16_t* ye = (const bf16_t*)(P.ws + OFF_A + 64 * MiB);
    const int* inv = (const int*)(P.ws + OFF_MISC + M_INV); const float* selg = (const float*)(P.ws + OFF_MISC + M_SELG);
    const float* g = P.ln2_g + layer * 1024; const float* bb = P.ln2_b + layer * 1024;
    for (long row0 = ((long)blockIdx.x * 4 + wid) * 2; row0 < T; row0 += (long)gridDim.x * 8) {
        const int b = (int)(row0 >> 11);
        f32x4 v[2][4]; int slotl[2]; u32x2 xr[2][4], pr[2][4];
#pragma unroll
        for (int r = 0; r < 2; ++r) {
            const long row = row0 + r;
            slotl[r] = lane < 16 ? inv[row * 16 + lane] : -1;
#pragma unroll
            for (int i = 0; i < 4; ++i) { const int col = i * 256 + lane * 4; xr[r][i] = *(const u32x2*)(x1h + row * 1024 + col); pr[r][i] = *(const u32x2*)(ple + row * 1024 + col); }
        }
        unsigned long long mask[2]; int nh[2]; u32x2 raw[2][4][4]; float gate[2][4];
#pragma unroll
        for (int r = 0; r < 2; ++r) {
            mask[r] = __ballot(slotl[r] >= 0); nh[r] = __popcll(mask[r]);
            unsigned long long m = mask[r];
#pragma unroll
            for (int k = 0; k < 4; ++k) {
                gate[r][k] = 0.f;
#pragma unroll
                for (int i = 0; i < 4; ++i) raw[r][k][i] = (u32x2){0u, 0u};
                if (k < nh[r]) {
                    const int e = __ffsll((long long)m) - 1; m &= m - 1;
                    const int slot = __builtin_amdgcn_readlane(slotl[r], e);
                    const long gr = (long)(b * 16 + e) * 256 + slot;
                    gate[r][k] = selg[gr];
#pragma unroll
                    for (int i = 0; i < 4; ++i) raw[r][k][i] = *(const u32x2*)(ye + gr * 1024 + i * 256 + lane * 4);
                }
            }
            mask[r] = m;
        }
#pragma unroll
        for (int r = 0; r < 2; ++r) {
            const long row = row0 + r;
#pragma unroll
            for (int i = 0; i < 4; ++i) {
                const f32x4 xv = {__uint_as_float(xr[r][i][0] << 16), __uint_as_float(xr[r][i][0] & 0xffff0000u), __uint_as_float(xr[r][i][1] << 16), __uint_as_float(xr[r][i][1] & 0xffff0000u)};
                const f32x4 pv = {__uint_as_float(pr[r][i][0] << 16), __uint_as_float(pr[r][i][0] & 0xffff0000u), __uint_as_float(pr[r][i][1] << 16), __uint_as_float(pr[r][i][1] & 0xffff0000u)};
                v[r][i] = xv * ALPHA + pv;
            }
#pragma unroll
            for (int k = 0; k < 4; ++k)
#pragma unroll
                for (int i = 0; i < 4; ++i) {
                    const f32x4 yv = {__uint_as_float(raw[r][k][i][0] << 16), __uint_as_float(raw[r][k][i][0] & 0xffff0000u), __uint_as_float(raw[r][k][i][1] << 16), __uint_as_float(raw[r][k][i][1] & 0xffff0000u)};
                    v[r][i] = v[r][i] + yv * gate[r][k];
                }
            unsigned long long m = mask[r];
            while (m) {
                const int e = __ffsll((long long)m) - 1; m &= m - 1;
                const int slot = __builtin_amdgcn_readlane(slotl[r], e);
                const long gr = (long)(b * 16 + e) * 256 + slot; const float gt = selg[gr];
#pragma unroll
                for (int i = 0; i < 4; ++i) v[r][i] = v[r][i] + ld_bf4(ye + gr * 1024 + i * 256 + lane * 4) * gt;
            }
            float s = 0.f;
#pragma unroll
            for (int i = 0; i < 4; ++i) s += (v[r][i][0] + v[r][i][1]) + (v[r][i][2] + v[r][i][3]);
            const float mean = wave_sum(s) * (1.f / 1024.f);
            float q = 0.f;
#pragma unroll
            for (int i = 0; i < 4; ++i) { v[r][i] = v[r][i] - mean; q += (v[r][i][0] * v[r][i][0] + v[r][i][1] * v[r][i][1]) + (v[r][i][2] * v[r][i][2] + v[r][i][3] * v[r][i][3]); }
            const float rstd = rsqrtf(wave_sum(q) * (1.f / 1024.f) + EPS);
#pragma unroll
            for (int i = 0; i < 4; ++i) { const int col = i * 256 + lane * 4; const f32x4 gg = *(const f32x4*)(g + col), bv = *(const f32x4*)(bb + col); const f32x4 y = v[r][i] * rstd * gg + bv; if (layer == 1) *(f32x4*)(P.out + row * 1024 + col) = y; else st_bf4(x1h + row * 1024 + col, y); }
        }
    }
}
DI void ph_win_odd(const Params& P, char* smem) {
    const bf16_t* x2h = (const bf16_t*)(P.ws + OFF_B);
    bf16_t* qkv = (bf16_t*)(P.ws + OFF_A);
    const bf16_t* Wt = (const bf16_t*)(P.ws + OFF_WS) + W_INO;
    const float* ropeC = (const float*)(P.ws + OFF_MISC + M_ROPEC);
    const float qscale = 0.125f * LOG2E;
    for (int blk, sl; xcd_pop(P, 7, 24, blk, sl, smem); ) {
        TILE_IDS
        const int mt = (blk / 3) * 16 + (sl >> 2), nt = (blk % 3) * 4 + (sl & 3);
        GP g{x2h, 1024, nullptr, mt * 256, Wt, 1024, nt * 128, 1536, 1024, 1};
        f32x4 acc[8][4]; zero_acc(acc);
        gemm_main(g, acc, smem);
        const int colw = nt * 128 + wc * 64;
        const int kind = colw < 1024 ? 0 : (colw < 1280 ? 1 : 2);
        const float* gn = kind == 0 ? P.gqa_q_norm : P.gqa_k_norm;
#pragma unroll
        for (int m = 0; m < 8; ++m) {
            const long row = mt * 256 + wr * 128 + m * 16 + fr; const int spos = (int)(row & (S - 1));
            bf16_t* dst = qkv + row * 1536 + colw + fq * 8;
            if (kind == 2) {
#pragma unroll
                for (int np = 0; np < 2; ++np) st_bf8(dst + np * 32, acc[m][2 * np], acc[m][2 * np + 1]);
            } else {
                float ss = 0.f;
#pragma unroll
                for (int n = 0; n < 4; ++n)
#pragma unroll
                    for (int j = 0; j < 4; ++j) ss += acc[m][n][j] * acc[m][n][j];
                ss += __shfl_xor(ss, 16); ss += __shfl_xor(ss, 32);
                const float rinv = rsqrtf(ss * (1.f / 64.f) + EPS) * (kind == 0 ? qscale : 1.f);
                f32x4 y[4];
#pragma unroll
                for (int n = 0; n < 4; ++n) { const f32x4 gg = *(const f32x4*)(gn + 32 * (n >> 1) + fq * 8 + 4 * (n & 1)); y[n] = acc[m][n] * rinv * gg; }
                f32x4 o1[2], o2[2];
#pragma unroll
                for (int n = 0; n < 2; ++n) {
                    const f32x4 c = *(const f32x4*)(ropeC + spos * 64 + fq * 8 + 4 * n), s = *(const f32x4*)(ropeC + spos * 64 + 32 + fq * 8 + 4 * n);
                    o1[n] = y[n] * c - y[n + 2] * s; o2[n] = y[n] * s + y[n + 2] * c;
                }
                st_bf8(dst, o1[0], o1[1]); st_bf8(dst + 32, o2[0], o2[1]);
            }
        }
    }
}

DI void ph_prologue(const Params& P, char* smem) {
    float* tile = (float*)smem;
    bf16_t* W = (bf16_t*)(P.ws + OFF_WS);
    conv_T(P.w_in_even, W + W_INE, 1, 1024, HE, 0, nullptr, 0, tile, (int)blockIdx.x, (int)gridDim.x);
    conv_T(P.w_uq, W + W_UQ, 1, 256, 768, 0, P.mla_q_norm, 0, tile, (int)blockIdx.x, (int)gridDim.x);
    conv_T(P.w_ukv, W + W_UKV, 1, 128, 1024, 0, P.mla_kv_norm, 0, tile, (int)blockIdx.x, (int)gridDim.x);
    conv_T(P.w_in_odd, W + W_INO, 1, 1024, 1536, 0, nullptr, 0, tile, (int)blockIdx.x, (int)gridDim.x);
    conv_T(P.w_o, W + W_O, 2, 1024, 1024, 1048576, nullptr, 0, tile, (int)blockIdx.x, (int)gridDim.x);
    conv_T(P.pg_w, W + W_PG, 2, 1024, 1024, 1048576, nullptr, 0, tile, (int)blockIdx.x, (int)gridDim.x);
    conv_T(P.ple_w, W + W_PW, 2, 256, 1024, 262144, nullptr, 0, tile, (int)blockIdx.x, (int)gridDim.x);
    { bf16_t* xb = (bf16_t*)(P.ws + OFF_C); bf16_t* pb = (bf16_t*)(P.ws + OFF_P);
      for (long i = ((long)blockIdx.x * NTHR + threadIdx.x) * 8; i < (long)T * 1024; i += (long)gridDim.x * NTHR * 8) {
          const f32x4 a = *(const f32x4*)(P.x + i), b = *(const f32x4*)(P.x + i + 4); u32x4 w = {pk2(a[0], a[1]), pk2(a[2], a[3]), pk2(b[0], b[1]), pk2(b[2], b[3])}; *(u32x4*)(xb + i) = w; }
      for (long i = ((long)blockIdx.x * NTHR + threadIdx.x) * 8; i < 2L * T * 256; i += (long)gridDim.x * NTHR * 8) {
          const f32x4 a = *(const f32x4*)(P.p + i), b = *(const f32x4*)(P.p + i + 4); u32x4 w = {pk2(a[0], a[1]), pk2(a[2], a[3]), pk2(b[0], b[1]), pk2(b[2], b[3])}; *(u32x4*)(pb + i) = w; } }
    float* ropeA = (float*)(P.ws + OFF_MISC + M_ROPEA); float* ropeC = (float*)(P.ws + OFF_MISC + M_ROPEC);
    for (int i = blockIdx.x * NTHR + threadIdx.x; i < S * 16; i += gridDim.x * NTHR) {
        const int s = i >> 4, k = i & 15; const int f = k & 7;
        const float invf = powf(10000.f, -(float)(2 * f) / 16.f);
        const float ang = (float)(k < 8 ? (s >> 6) : (s & 63)) * invf;
        ropeA[s * 32 + k] = cosf(ang); ropeA[s * 32 + 16 + k] = sinf(ang);
    }
    for (int i = blockIdx.x * NTHR + threadIdx.x; i < S * 32; i += gridDim.x * NTHR) {
        const int s = i >> 5, k = i & 31; const int f = k & 15;
        const float invf = powf(10000.f, -(float)(2 * f) / 32.f);
        const float ang = (float)(k < 16 ? (s >> 6) : (s & 63)) * invf;
        ropeC[s * 64 + k] = cosf(ang); ropeC[s * 64 + 32 + k] = sinf(ang);
    }
}

#define XB_TMO      128
#define XB_XCNT(j)  (256  + 64 * (j))
#define XB_XSUB(j)  (1280 + 64 * (j))
#define XB_XGEN(j)  (2304 + 64 * (j))
#define XB_TOP      3328
#define XB_TOPGEN   3392
#define XCD_BAR_WORDS 3456
#define XB_SPIN_CAP (1u << 22)
#define LAS __attribute__((address_space(3)))

__device__ __forceinline__ unsigned xb_ld(unsigned* p)              { return __hip_atomic_load(p, __ATOMIC_RELAXED, __HIP_MEMORY_SCOPE_AGENT); }
__device__ __forceinline__ unsigned xb_add(unsigned* p, unsigned v) { return __hip_atomic_fetch_add(p, v, __ATOMIC_RELAXED, __HIP_MEMORY_SCOPE_AGENT); }
__device__ __forceinline__ unsigned xb_xcc_id() { return (unsigned)__builtin_amdgcn_s_getreg((3 << 11) | 20) & 0xFu; }
#define XB_SPIN(cond, bar) do { unsigned _sp = 0; while (cond) { __builtin_amdgcn_s_sleep(1); \
    if ((++_sp & 255u) == 0u) { if (xb_ld(&(bar)[XB_TMO])) break; if (_sp > XB_SPIN_CAP) { atomicAdd(&(bar)[XB_TMO], 1u); break; } } } } while (0)

struct XcdBarrier {
    unsigned* bar; unsigned x;
    volatile LAS unsigned* st;
};

__device__ __forceinline__ XcdBarrier xcd_barrier_post(unsigned* bar, volatile LAS unsigned* st) {
    XcdBarrier b; b.bar = bar; b.x = xb_xcc_id(); b.st = st;
    if (threadIdx.x == 0) (void)xb_add(&bar[XB_XCNT(b.x)], 1u);
    return b;
}
__device__ __forceinline__ void xcd_barrier_complete(unsigned* bar, unsigned x, unsigned& nloc, unsigned& nx) {
    const unsigned G = gridDim.x * gridDim.y * gridDim.z;
    unsigned sum, cnt, mine, sp = 0u;
    for (;;) {
        sum = 0u; cnt = 0u; mine = 0u;
#pragma unroll
        for (unsigned j = 0; j < 16; ++j) { const unsigned c = xb_ld(&bar[XB_XCNT(j)]); sum += c; cnt += (c > 0u) ? 1u : 0u; mine = (j == x) ? c : mine; }
        if (sum == G) break;
        __builtin_amdgcn_s_sleep(1);
        if ((++sp & 255u) == 0u) { if (xb_ld(&bar[XB_TMO])) break; if (sp > XB_SPIN_CAP) { atomicAdd(&bar[XB_TMO], 1u); break; } }
    }
    nloc = mine > 0u ? mine : 1u; nx = cnt > 0u ? cnt : 1u;
}

__device__ __forceinline__ void xcd_barrier(const XcdBarrier& b) {
    asm volatile("s_waitcnt vmcnt(0)" ::: "memory");
    __syncthreads();
    if (threadIdx.x == 0) {
        unsigned* bar = b.bar;
        __builtin_amdgcn_s_waitcnt(0);
        unsigned nloc = b.st[0], nx = b.st[1];
        if (nloc == 0u) { xcd_barrier_complete(bar, b.x, nloc, nx); b.st[0] = nloc; b.st[1] = nx; }
        const unsigned old = xb_add(&bar[XB_XSUB(b.x)], 1u);
        const unsigned gen = old / nloc;
        if (old + 1u == (gen + 1u) * nloc) {
            __builtin_amdgcn_fence(__ATOMIC_RELEASE, "agent");
            asm volatile("s_waitcnt vmcnt(0)" ::: "memory");
            const unsigned og = xb_add(&bar[XB_TOP], 1u);
            const unsigned tg = og / nx;
            if (og + 1u == (tg + 1u) * nx) xb_add(&bar[XB_TOPGEN], 1u);
            else XB_SPIN(xb_ld(&bar[XB_TOPGEN]) == tg, bar);
            __builtin_amdgcn_fence(__ATOMIC_ACQUIRE, "agent");
            xb_add(&bar[XB_XGEN(b.x)], 1u);
            asm volatile("s_waitcnt vmcnt(0)" ::: "memory");
        } else {
            XB_SPIN(xb_ld(&bar[XB_XGEN(b.x)]) == gen, bar);
            __builtin_amdgcn_fence(__ATOMIC_ACQUIRE, "agent");
            asm volatile("s_waitcnt vmcnt(0)" ::: "memory");
        }
    }
    __syncthreads();
}

constexpr int NPHASE = 19;
__global__ void __launch_bounds__(NTHR, 2) mk(Params P, int ph_lo, int ph_hi) {
    extern __shared__ __attribute__((aligned(16))) char smem[];
    cg::grid_group grid = cg::this_grid();
    if (ph_lo > 1000) grid.sync();
    volatile LAS unsigned* xb_st = (volatile LAS unsigned*)(smem + LDS_BYTES - 16);
    if (threadIdx.x == 0) { xb_st[0] = 0u; xb_st[1] = 0u; xb_st[2] = 0u; xb_st[3] = 0u; }
    __syncthreads();
    XcdBarrier xb = xcd_barrier_post((unsigned*)(P.ws + OFF_MISC + M_BAR), xb_st);
#ifndef REP_MOE
#define REP_MOE 1
#endif
#ifndef REP_GEMM
#define REP_GEMM 1
#endif
#ifndef REP_ATT
#define REP_ATT 1
#endif
#ifndef REP_MISC
#define REP_MISC 1
#endif
#define PH(k_, body_) if (ph_lo <= (k_) && (k_) < ph_hi) { if ((k_) > ph_lo) xcd_barrier(xb); body_ }
#define RP(n_, body_) for (int rep_ = 0; rep_ < (n_); ++rep_) { body_ }
    PH(0, RP(REP_MISC, ph_prologue(P, smem);))
    PH(1, RP(REP_GEMM, ph_win_even(P, smem);))
    PH(2, RP(REP_GEMM, ph_uq(P, smem); ph_ukv(P, smem);) ph_kpe(P); RP(REP_MISC, ph_gla1(P, smem);))
    PH(3, ph_gla2(P);
          if (gridDim.x == 512) { if (((((blockIdx.x >> 8) ^ (blockIdx.x >> 3)) & 1)) == 0) conv_moe(P, 0, (float*)smem, (int)(blockIdx.x & 255), 256); }
          else conv_moe(P, 0, (float*)smem, (int)blockIdx.x, (int)gridDim.x);
          ph_attn_mla(P, smem);)
    PH(4, RP(REP_MISC, ph_gla3(P, smem);))
    PH(5, RP(REP_GEMM, ph_wo(P, 0, smem);))
    PH(6, RP(REP_MISC, ph_ln1_router(P, 0, smem);))
    PH(7, RP(REP_MISC, ph_topk(P, smem);) RP(REP_GEMM, ph_ple(P, 0, smem);))
    PH(8, ph_moe1(P, smem, 0);)
    PH(9, ph_moe2(P, smem, 0);)
    PH(10, ph_ln2(P, 0);)
    PH(11, RP(REP_GEMM, ph_win_odd(P, smem);))
    PH(12,
          if (gridDim.x == 512) { if (((((blockIdx.x >> 8) ^ (blockIdx.x >> 3)) & 1)) == 0) conv_moe(P, 1, (float*)smem, (int)(blockIdx.x & 255), 256); }
          else conv_moe(P, 1, (float*)smem, (int)blockIdx.x, (int)gridDim.x);
          ph_attn_gqa(P, smem);)
    PH(13, RP(REP_GEMM, ph_wo(P, 1, smem);))
    PH(14, RP(REP_MISC, ph_ln1_router(P, 1, smem);))
    PH(15, RP(REP_MISC, ph_topk(P, smem);) RP(REP_GEMM, ph_ple(P, 1, smem);))
    PH(16, ph_moe1(P, smem, 1);)
    PH(17, ph_moe2(P, smem, 1);)
    PH(18, ph_ln2(P, 1);)
}

extern "C" void kernel_launch(void* const* d_in, const int* in_sizes, int n_in, void* d_out, int out_size, void* d_ws, size_t ws_size, hipStream_t stream) {
    static int grid_blocks = 0;
    if (grid_blocks == 0) {
        if (n_in != 27 || ws_size < (size_t)WS_END) { fprintf(stderr, "kernel_launch: unexpected n_in %d or ws_size %zu (need %ld)\n", n_in, ws_size, (long)WS_END); grid_blocks = -1; return; }
        int dev = 0, cus = 0, per_cu = 0;
        hipGetDevice(&dev);
        hipDeviceGetAttribute(&cus, hipDeviceAttributeMultiprocessorCount, dev);
        hipFuncSetAttribute((const void*)mk, hipFuncAttributeMaxDynamicSharedMemorySize, LDS_BYTES);
        hipOccupancyMaxActiveBlocksPerMultiprocessor(&per_cu, (const void*)mk, NTHR, LDS_BYTES);
        if (per_cu < 1) { fprintf(stderr, "kernel_launch: occupancy query returned %d\n", per_cu); grid_blocks = -1; return; }
        if (per_cu > 2) per_cu = 2;
        grid_blocks = cus * per_cu;
        fprintf(stderr, "kernel_launch: cus %d per_cu %d grid %d ws %zu\n", cus, per_cu, grid_blocks, ws_size);
    }
    if (grid_blocks < 0) return;
    Params P{};
    const float** pp = (const float**)&P;
    for (int i = 0; i < 27; ++i) pp[i] = (const float*)d_in[i];
    P.out = (float*)d_out; P.ws = (char*)d_ws;
    if (hipMemsetAsync((char*)d_ws + OFF_MISC + M_BAR, 0, CTL_BYTES, stream) != hipSuccess) { fprintf(stderr, "memset failed\n"); return; }
    int lo = 0, hi = NPHASE;
    void* args[] = {&P, &lo, &hi};
    hipError_t e = hipLaunchCooperativeKernel((const void*)mk, dim3(grid_blocks), dim3(NTHR), args, LDS_BYTES, stream);
    if (e != hipSuccess) fprintf(stderr, "cooperative launch failed: %s (grid %d)\n", hipGetErrorString(e), grid_blocks);
}
```

```cpp
#include <hip/hip_runtime.h>
#include <hip/hip_cooperative_groups.h>
#include <cstdio>
#include <cstdint>
namespace cg = cooperative_groups;

typedef unsigned short bf16_t;
typedef short bf16x8 __attribute__((ext_vector_type(8)));
typedef short s16x4 __attribute__((ext_vector_type(4)));
typedef float f32x4 __attribute__((ext_vector_type(4)));
typedef unsigned u32x4 __attribute__((ext_vector_type(4)));
typedef unsigned u32x2 __attribute__((ext_vector_type(2)));
#define DI __device__ __forceinline__
#define MFMA16(a, b, c) __builtin_amdgcn_mfma_f32_16x16x32_bf16((a), (b), (c), 0, 0, 0)

constexpr int T = 32768, S = 2048, NB = 16, D = 1024, HE = 1984, NTHR = 256;
constexpr float EPS = 1e-6f;
constexpr float ALPHA = 1.41421356237f;
constexpr float LOG2E = 1.44269504089f;
constexpr long MiB = 1 << 20;
constexpr long M_BAR = 7 * MiB;
constexpr long M_QCTR = M_BAR + 16384;
constexpr int CTL_BYTES = 16384 + 32 * 8 * 64;
constexpr long OFF_WS = 0, OFF_MISC = 17 * MiB, OFF_WMOE = 25 * MiB, OFF_A = 121 * MiB, OFF_B = 313 * MiB, OFF_C = 441 * MiB, OFF_D = 505 * MiB, OFF_P = 569 * MiB, WS_END = 601 * MiB;
constexpr long W_INE = 0, W_UQ = 2031616, W_UKV = 2228224, W_INO = 2359296, W_O = 3932160, W_PG = 6029312, W_PW = 8126464;
constexpr long M_ROPEA = 0, M_ROPEC = 256 * 1024, M_AFF = 1 * MiB, M_SELI = 3 * MiB, M_SELG = 3 * MiB + 256 * 1024, M_INV = 4 * MiB, M_DEC = 6 * MiB;
constexpr int H_CQ = 0, H_CKV = 256, H_KPE = 384, H_GQ = 416, H_GK = 672, H_GV = 928, H_LR = 1440, H_GR = 1472;
constexpr int LDS_BYTES = 73728 + 1024 + 256;

struct Params {
    const float *x, *p, *w_in_even, *mla_q_norm, *w_uq, *mla_kv_norm, *w_ukv, *gw_f, *gb_f, *gw_b, *gb_b, *gla_norm, *w_in_odd, *gqa_q_norm, *gqa_k_norm,
        *w_o, *ln1_g, *ln1_b, *router_w, *w1, *w3, *w2, *pg_w, *pg_b, *ple_w, *ln2_g, *ln2_b;
    float* out; char* ws;
};

DI float bf2f(bf16_t v) { return __uint_as_float(((unsigned)v) << 16); }
typedef float f32x2 __attribute__((ext_vector_type(2)));
typedef __bf16 bf16v2 __attribute__((ext_vector_type(2)));
DI unsigned pk2(float lo, float hi) { f32x2 v = {lo, hi}; bf16v2 b = __builtin_convertvector(v, bf16v2); return __builtin_bit_cast(unsigned, b); }
DI bf16_t f2bf(float x) { return (bf16_t)(pk2(x, 0.f) & 0xffffu); }
DI void st_bf4(bf16_t* dst, f32x4 v) { u32x2 w; w[0] = pk2(v[0], v[1]); w[1] = pk2(v[2], v[3]); *(u32x2*)dst = w; }
DI void st_bf8(bf16_t* dst, f32x4 a, f32x4 b) { u32x4 w; w[0] = pk2(a[0], a[1]); w[1] = pk2(a[2], a[3]); w[2] = pk2(b[0], b[1]); w[3] = pk2(b[2], b[3]); *(u32x4*)dst = w; }
DI f32x4 ld_bf4(const bf16_t* src) { u32x2 w = *(const u32x2*)src; f32x4 r; r[0] = __uint_as_float(w[0] << 16); r[1] = __uint_as_float(w[0] & 0xffff0000u); r[2] = __uint_as_float(w[1] << 16); r[3] = __uint_as_float(w[1] & 0xffff0000u); return r; }
DI float wave_sum(float v) {
#pragma unroll
    for (int o = 32; o > 0; o >>= 1) v += __shfl_xor(v, o);
    return v;
}

DI void conv_T(const float* src, bf16_t* dst, int nb, int K, int N, long dst_bstride, const float* gain, int mode, float* tile, int vb, int vg) {
    const int t = threadIdx.x, tk = K / 64, tn = N / 64, per = tk * tn, total = nb * per;
    for (int it = vb; it < total; it += vg) {
        const int b = it / per, r = it % per, kt = r / tn, nt = r % tn;
        const float* s = src + (long)b * K * N + (long)kt * 64 * N + nt * 64;
#pragma unroll
        for (int i = 0; i < 4; ++i) {
            const int kk = (t >> 4) + 16 * i;
            float4 v = *(const float4*)(s + (long)kk * N + (t & 15) * 4);
            const float gs = gain ? gain[kt * 64 + kk] : 1.f;
            float* d = tile + kk * 65 + (t & 15) * 4;
            d[0] = v.x * gs; d[1] = v.y * gs; d[2] = v.z * gs; d[3] = v.w * gs;
        }
        __syncthreads();
        const int nl = t >> 2, kc = (t & 3) * 16, n = nt * 64 + nl;
        const int drow = (mode == 0) ? n : ((n >> 5) * 64 + (mode - 1) * 32 + (n & 31));
        unsigned w[8];
#pragma unroll
        for (int j = 0; j < 8; ++j) w[j] = pk2(tile[(kc + 2 * j) * 65 + nl], tile[(kc + 2 * j + 1) * 65 + nl]);
        bf16_t* d = dst + (long)b * dst_bstride + (long)drow * K + kt * 64 + kc;
        *(u32x4*)d = (u32x4){w[0], w[1], w[2], w[3]};
        *(u32x4*)(d + 8) = (u32x4){w[4], w[5], w[6], w[7]};
        __syncthreads();
    }
}

DI void conv_moe(const Params& P, int layer, float* tile, int vb, int vg) {
    bf16_t* w13 = (bf16_t*)(P.ws + OFF_WMOE);
    bf16_t* w2t = w13 + 16L * 2048 * 1024;
    const long lo = (long)layer * 16 * 1024 * 1024;
    conv_T(P.w1 + lo, w13, 16, 1024, 1024, 2048L * 1024, nullptr, 1, tile, vb, vg);
    conv_T(P.w3 + lo, w13, 16, 1024, 1024, 2048L * 1024, nullptr, 2, tile, vb, vg);
    conv_T(P.w2 + lo, w2t, 16, 1024, 1024, 1024L * 1024, nullptr, 0, tile, vb, vg);
}

struct GP { const bf16_t* A; long lda; const int* rowidx; int m0; const bf16_t* Bt; long ldb; int n0; int N; int K; int perm; };
constexpr int LDT = 72;
constexpr int STG = 384 * 64;
constexpr int RS_OFF = 3 * STG;
#define LAS3 __attribute__((address_space(3)))

DI int opaque_tid();
DI void gemm_main(const GP& g, f32x4 (&acc)[8][4], char* smem) {
    const int t = opaque_tid(), lane = t & 63, wid = t >> 6, wr = wid >> 1, wc = wid & 1, fr = lane & 15, fq = lane >> 4;
    unsigned ao[4], bo[2];
    const char* Ab = (const char*)g.A; const char* Bb = (const char*)g.Bt;
#pragma unroll
    for (int j = 0; j < 4; ++j) {
        const int row = (wid * 4 + j) * 16 + (lane >> 2), c = (lane & 3) ^ (((row >> 3) & 1) << 1);
        const long grow = g.rowidx ? (long)g.rowidx[g.m0 + row] : (long)(g.m0 + row);
        ao[j] = (unsigned)((grow * g.lda + c * 8) * 2);
    }
#pragma unroll
    for (int j = 0; j < 2; ++j) {
        const int row = (wid * 2 + j) * 16 + (lane >> 2), c = (lane & 3) ^ (((row >> 3) & 1) << 1);
        const int rho = row & 31, prow = g.perm ? ((row & ~31) | (8 * ((rho & 15) >> 2) + 4 * (rho >> 4) + (rho & 3))) : row;
        int brow = g.n0 + prow; brow = brow < g.N ? brow : g.N - 1;
        bo[j] = (unsigned)(((long)brow * g.ldb + c * 8) * 2);
    }
#define GLDS(kt_, st_) { \
        _Pragma("unroll") for (int j = 0; j < 4; ++j) __builtin_amdgcn_global_load_lds((const unsigned*)(Ab + (ao[j] + (unsigned)(kt_) * 64u)), (LAS3 unsigned*)(smem + (st_) * STG + (wid * 4 + j) * 1024), 16, 0, 0); \
        _Pragma("unroll") for (int j = 0; j < 2; ++j) __builtin_amdgcn_global_load_lds((const unsigned*)(Bb + (bo[j] + (unsigned)(kt_) * 64u)), (LAS3 unsigned*)(smem + (st_) * STG + 16384 + (wid * 2 + j) * 1024), 16, 0, 0); }
    const int nk = g.K / 32;
    const int pc8 = (fq ^ (((fr >> 3) & 1) << 1)) * 8;
    GLDS(0, 0)
    if (nk > 1) GLDS(1, 1)
    int sc = 0, sl = 2;
    for (int kt = 0; kt < nk; ++kt) {
        if (kt + 1 < nk) asm volatile("s_waitcnt vmcnt(6)" ::: "memory"); else asm volatile("s_waitcnt vmcnt(0)" ::: "memory");
        __builtin_amdgcn_s_barrier();
        asm volatile("" ::: "memory");
        if (kt + 2 < nk) GLDS(kt + 2, sl)
        const bf16_t* sA = (const bf16_t*)(smem + sc * STG); const bf16_t* sB = sA + 256 * 32;
        bf16x8 b[4];
#pragma unroll
        for (int n = 0; n < 4; ++n) b[n] = *(const bf16x8*)(sB + (wc * 64 + n * 16 + fr) * 32 + pc8);
#pragma unroll
        for (int mh = 0; mh < 4; ++mh) {
            bf16x8 a[2];
#pragma unroll
            for (int m = 0; m < 2; ++m) a[m] = *(const bf16x8*)(sA + (wr * 128 + (mh * 2 + m) * 16 + fr) * 32 + pc8);
#pragma unroll
            for (int m = 0; m < 2; ++m)
#pragma unroll
                for (int n = 0; n < 4; ++n) acc[mh * 2 + m][n] = MFMA16(b[n], a[m], acc[mh * 2 + m][n]);
        }
        sc = sc == 2 ? 0 : sc + 1; sl = sl == 2 ? 0 : sl + 1;
    }
    __syncthreads();
}
DI void zero_acc(f32x4 (&acc)[8][4]) {
#pragma unroll
    for (int m = 0; m < 8; ++m)
#pragma unroll
        for (int n = 0; n < 4; ++n) acc[m][n] = (f32x4){0.f, 0.f, 0.f, 0.f};
}
DI int opaque_tid() { int t = threadIdx.x; asm volatile("" : "+v"(t)); return t; }
#define TILE_IDS const int t = opaque_tid(), lane = t & 63, wid = t >> 6, wr = wid >> 1, wc = wid & 1, fr = lane & 15, fq = lane >> 4; (void)lane; (void)wr; (void)wc; (void)fr; (void)fq; (void)t;

DI bool xcd_next(int it, int nblk, int& blk, int& sl) {
    const int x = blockIdx.x & 7, s = blockIdx.x >> 3, ns = gridDim.x >> 3;
    const int q = it * ns + s;
    blk = (q >> 6) * 8 + x; sl = q & 63;
    return blk < nblk;
}

DI bool xcd_pop(const Params& P, int queue, int nblk, int& blk, int& sl, char* smem) {
    volatile int* slot = (volatile int*)(smem + LDS_BYTES - 64);
    const int x = blockIdx.x & 7;
    __syncthreads();
    if (threadIdx.x == 0) {
        unsigned* ctr = (unsigned*)(P.ws + OFF_MISC + M_QCTR) + (queue * 8 + x) * 16;
        slot[0] = (int)__hip_atomic_fetch_add(ctr, 1u, __ATOMIC_RELAXED, __HIP_MEMORY_SCOPE_AGENT);
    }
    __syncthreads();
    const int q = slot[0];
    blk = (q >> 6) * 8 + x; sl = q & 63;
    return blk < nblk;
}

DI void row_rms(const bf16_t* A, long lda, int m0, int K, float* rs) {
    const int t = threadIdx.x;
    const bf16_t* p = A + (long)(m0 + t) * lda;
    float ss = 0.f;
    for (int i = 0; i < K; i += 8) {
        const u32x4 v = *(const u32x4*)(p + i);
#pragma unroll
        for (int j = 0; j < 4; ++j) { float a = __uint_as_float(v[j] << 16), b = __uint_as_float(v[j] & 0xffff0000u); ss += a * a + b * b; }
    }
    rs[t] = rsqrtf(ss / (float)K + EPS);
}

DI void ph_win_even(const Params& P, char* smem) {
    bf16_t* h = (bf16_t*)(P.ws + OFF_A);
    const bf16_t* xb = (const bf16_t*)(P.ws + OFF_C);
    const bf16_t* Wt = (const bf16_t*)(P.ws + OFF_WS) + W_INE;
    for (int blk, sl; xcd_pop(P, 0, 32, blk, sl, smem); ) {
        TILE_IDS
        const int mt = (blk >> 1) * 8 + (sl >> 3), nt = (blk & 1) * 8 + (sl & 7);
        GP g{xb, 1024, nullptr, mt * 256, Wt, 1024, nt * 128, HE, 1024, 1};
        f32x4 acc[8][4]; zero_acc(acc);
        gemm_main(g, acc, smem);
#pragma unroll
        for (int m = 0; m < 8; ++m) {
            const long row = mt * 256 + wr * 128 + m * 16 + fr;
#pragma unroll
            for (int np = 0; np < 2; ++np) {
                const int col = nt * 128 + wc * 64 + np * 32 + fq * 8;
                if (col < HE) st_bf8(h + row * HE + col, acc[m][2 * np], acc[m][2 * np + 1]);
            }
        }
    }
}

DI void ph_uq(const Params& P, char* smem) {
    float* rs = (float*)(smem + RS_OFF);
    const bf16_t* h = (const bf16_t*)(P.ws + OFF_A);
    bf16_t* Qm = (bf16_t*)(P.ws + OFF_B);
    const bf16_t* Wt = (const bf16_t*)(P.ws + OFF_WS) + W_UQ;
    const float* ropeA = (const float*)(P.ws + OFF_MISC + M_ROPEA);
    const float qscale = 0.10206207261596577f * LOG2E;
    for (int it = 0, blk, sl; xcd_next(it, 12, blk, sl); ++it) {
        TILE_IDS
        const int mt = (blk / 3) * 32 + (sl >> 1), nt = (blk % 3) * 2 + (sl & 1);
        row_rms(h + H_CQ, HE, mt * 256, 256, rs);
        GP g{h + H_CQ, HE, nullptr, mt * 256, Wt, 256, nt * 128, 768, 256};
        f32x4 acc[8][4]; zero_acc(acc);
        gemm_main(g, acc, smem);
        const int tau0 = (nt * 128 + wc * 64) >> 4;
#pragma unroll
        for (int m = 0; m < 8; ++m) {
            const int rl = wr * 128 + m * 16 + fr; const long row = mt * 256 + rl;
            const float sc = rs[rl] * qscale; const int spos = (int)(row & (S - 1));
#pragma unroll
            for (int n = 0; n < 4; ++n) {
                const int r6 = (tau0 + n) % 6; const int col = nt * 128 + wc * 64 + n * 16 + fq * 4;
                if (r6 < 4) { st_bf4(Qm + row * 768 + col, acc[m][n] * sc); }
                else if (r6 == 4 && n < 3) {
                    f32x4 x1 = acc[m][n] * sc, x2 = acc[m][n + 1 < 4 ? n + 1 : n] * sc, o1, o2;
                    const float* cs = ropeA + spos * 32 + fq * 4;
#pragma unroll
                    for (int j = 0; j < 4; ++j) { const float c = cs[j], s = cs[16 + j]; o1[j] = x1[j] * c - x2[j] * s; o2[j] = x1[j] * s + x2[j] * c; }
                    st_bf4(Qm + row * 768 + col, o1); st_bf4(Qm + row * 768 + col + 16, o2);
                }
            }
        }
        __syncthreads();
    }
}
DI void ph_ukv(const Params& P, char* smem) {
    float* rs = (float*)(smem + RS_OFF);
    const bf16_t* h = (const bf16_t*)(P.ws + OFF_A);
    bf16_t* Kc = (bf16_t*)(P.ws + OFF_B + 48 * MiB); bf16_t* Vm = (bf16_t*)(P.ws + OFF_B + 96 * MiB);
    const bf16_t* Wt = (const bf16_t*)(P.ws + OFF_WS) + W_UKV;
    for (int it = 0, blk, sl; xcd_next(it, 16, blk, sl); ++it) {
        TILE_IDS
        const int mt = blk * 8 + (sl >> 3), nt = sl & 7;
        row_rms(h + H_CKV, HE, mt * 256, 128, rs);
        GP g{h + H_CKV, HE, nullptr, mt * 256, Wt, 128, nt * 128, 1024, 128, 1};
        f32x4 acc[8][4]; zero_acc(acc);
        gemm_main(g, acc, smem);
#pragma unroll
        for (int m = 0; m < 8; ++m) {
            const int rl = wr * 128 + m * 16 + fr; const long row = mt * 256 + rl; const float sc = rs[rl];
#pragma unroll
            for (int np = 0; np < 2; ++np) {
                const int c = np * 32 + fq * 8;
                if (wc == 0) st_bf8(Kc + row * 768 + nt * 96 + c, acc[m][2 * np] * sc, acc[m][2 * np + 1] * sc);
                else st_bf8(Vm + row * 512 + nt * 64 + c, acc[m][2 * np] * sc, acc[m][2 * np + 1] * sc);
            }
        }
        __syncthreads();
    }
}
DI void ph_kpe(const Params& P) {
    const bf16_t* h = (const bf16_t*)(P.ws + OFF_A);
    bf16_t* Kc = (bf16_t*)(P.ws + OFF_B + 48 * MiB);
    const float* ropeA = (const float*)(P.ws + OFF_MISC + M_ROPEA);
    for (long i = (long)blockIdx.x * NTHR + threadIdx.x; i < (long)T * 8; i += (long)gridDim.x * NTHR) {
        const long tok = i >> 3; const int hd = (int)(i & 7), spos = (int)(tok & (S - 1));
        const bf16_t* src = h + tok * HE + H_KPE; const float* cs = ropeA + spos * 32;
        bf16_t* dst = Kc + tok * 768 + hd * 96 + 64;
#pragma unroll
        for (int q4 = 0; q4 < 4; ++q4) {
            const f32x4 x1 = ld_bf4(src + q4 * 4), x2 = ld_bf4(src + 16 + q4 * 4), c = *(const f32x4*)(cs + q4 * 4), s = *(const f32x4*)(cs + 16 + q4 * 4);
            st_bf4(dst + q4 * 4, x1 * c - x2 * s); st_bf4(dst + 16 + q4 * 4, x1 * s + x2 * c);
        }
    }
}

DI float logsig(float z) { return fminf(z, 0.f) - __logf(1.f + __expf(-fabsf(z))); }
DI void gla_cum(const Params& P, int dir, const bf16_t* hrow0, int hh, char* smem) {
    float* s_cum = (float*)smem; float* s_lr = (float*)(smem + 16384); float* s_seg = (float*)(smem + 20480); float* s_tot = (float*)(smem + 21504);
    const int t = threadIdx.x;
    const int d = t & 63, lq = t >> 6;
    const float* gw = dir ? P.gw_b : P.gw_f; const float* gb = dir ? P.gb_b : P.gb_f;
    float w[16];
#pragma unroll
    for (int r = 0; r < 16; ++r) w[r] = gw[r * 256 + hh * 64 + d];
    const float bias = gb[hh * 64 + d];
    { const int l = t >> 2, r4 = (t & 3) * 4; f32x4 v = ld_bf4(hrow0 + (long)l * HE + H_LR + dir * 16 + r4);
      s_lr[l * 16 + r4] = v[0]; s_lr[l * 16 + r4 + 1] = v[1]; s_lr[l * 16 + r4 + 2] = v[2]; s_lr[l * 16 + r4 + 3] = v[3]; }
    __syncthreads();
    float la[16];
#pragma unroll
    for (int li = 0; li < 16; ++li) {
        const float* lr = s_lr + (lq * 16 + li) * 16; float z = bias;
#pragma unroll
        for (int r = 0; r < 16; ++r) z += lr[r] * w[r];
        la[li] = logsig(z) * 0.0625f;
    }
    if (dir == 0) {
#pragma unroll
        for (int li = 1; li < 16; ++li) la[li] += la[li - 1];
        s_seg[lq * 64 + d] = la[15];
    } else {
#pragma unroll
        for (int li = 14; li >= 0; --li) la[li] += la[li + 1];
        s_seg[lq * 64 + d] = la[0];
    }
    __syncthreads();
    float off = 0.f, tot = 0.f;
#pragma unroll
    for (int q = 0; q < 4; ++q) { const float sg = s_seg[q * 64 + d]; tot += sg; if (dir == 0 ? (q < lq) : (q > lq)) off += sg; }
#pragma unroll
    for (int li = 0; li < 16; ++li) s_cum[(lq * 16 + li) * 64 + d] = la[li] + off;
    if (lq == 0) s_tot[d] = tot;
    __syncthreads();
}
DI void gla_load_vt(const bf16_t* hrow0, int hh, char* smem) {
    bf16_t* Vt = (bf16_t*)(smem + 40960);
    const int t = threadIdx.x;
#pragma unroll
    for (int i = 0; i < 4; ++i) {
        const int c = t + 256 * i, l = c >> 4, e8 = (c & 15) * 8;
        const u32x4 v = *(const u32x4*)(hrow0 + (long)l * HE + H_GV + hh * 128 + e8);
#pragma unroll
        for (int j = 0; j < 4; ++j) { Vt[(e8 + 2 * j) * LDT + l] = (bf16_t)(v[j] & 0xffffu); Vt[(e8 + 2 * j + 1) * LDT + l] = (bf16_t)(v[j] >> 16); }
    }
}
DI void ph_gla1(const Params& P, char* smem) {
    TILE_IDS
    const bf16_t* h = (const bf16_t*)(P.ws + OFF_A);
    bf16_t* UT = (bf16_t*)(P.ws + OFF_C); float* DEC = (float*)(P.ws + OFF_MISC + M_DEC);
    float* s_cum = (float*)smem; float* s_tot = (float*)(smem + 21504);
    bf16_t* KDt = (bf16_t*)(smem + 22528); bf16_t* Vt = (bf16_t*)(smem + 40960);
    for (int unit = blockIdx.x; unit < NB * 4 * 32; unit += gridDim.x) {
        const int c = unit & 31, hh = (unit >> 5) & 3, b = unit >> 7;
        const bf16_t* hrow0 = h + ((long)b * S + c * 64) * HE;
        gla_load_vt(hrow0, hh, smem);
        for (int dir = 0; dir < 2; ++dir) {
            u32x2 kraw[4];
            { const int l = t >> 2, dc = (t & 3) * 16;
              const bf16_t* kp = hrow0 + (long)l * HE + H_GK + hh * 64 + dc;
#pragma unroll
              for (int q4 = 0; q4 < 4; ++q4) kraw[q4] = *(const u32x2*)(kp + q4 * 4); }
            gla_cum(P, dir, hrow0, hh, smem);
            { const int l = t >> 2, dc = (t & 3) * 16;
#pragma unroll
              for (int q4 = 0; q4 < 4; ++q4) {
                  const f32x4 kv = {__uint_as_float(kraw[q4][0] << 16), __uint_as_float(kraw[q4][0] & 0xffff0000u), __uint_as_float(kraw[q4][1] << 16), __uint_as_float(kraw[q4][1] & 0xffff0000u)};
#pragma unroll
                  for (int j = 0; j < 4; ++j) { const int d = dc + q4 * 4 + j; KDt[d * LDT + l] = f2bf(kv[j] * __expf(s_tot[d] - s_cum[l * 64 + d])); } } }
            __syncthreads();
            const long u = ((long)(b * 4 + hh) * 2 + dir) * 32 + c;
            if (t < 64) DEC[u * 64 + t] = __expf(s_tot[t]);
            f32x4 acc[2][4];
#pragma unroll
            for (int e = 0; e < 2; ++e)
#pragma unroll
                for (int dt = 0; dt < 4; ++dt) acc[e][dt] = (f32x4){0.f, 0.f, 0.f, 0.f};
#pragma unroll
            for (int ks = 0; ks < 2; ++ks) {
                bf16x8 vf[2], kf[4];
#pragma unroll
                for (int e = 0; e < 2; ++e) vf[e] = *(const bf16x8*)(Vt + ((wid * 2 + e) * 16 + fr) * LDT + ks * 32 + fq * 8);
#pragma unroll
                for (int dt = 0; dt < 4; ++dt) kf[dt] = *(const bf16x8*)(KDt + (dt * 16 + fr) * LDT + ks * 32 + fq * 8);
#pragma unroll
                for (int e = 0; e < 2; ++e)
#pragma unroll
                    for (int dt = 0; dt < 4; ++dt) acc[e][dt] = MFMA16(kf[dt], vf[e], acc[e][dt]);
            }
            bf16_t* ut = UT + u * 8192;
#pragma unroll
            for (int e = 0; e < 2; ++e)
#pragma unroll
                for (int dt = 0; dt < 4; ++dt) st_bf4(ut + ((wid * 2 + e) * 16 + fr) * 64 + dt * 16 + fq * 4, acc[e][dt]);
            __syncthreads();
        }
    }
}
DI void ph_gla2(const Params& P) {
    bf16_t* UT = (bf16_t*)(P.ws + OFF_C); const float* DEC = (const float*)(P.ws + OFF_MISC + M_DEC);
    for (int item = blockIdx.x; item < 128 * 4; item += gridDim.x) {
        const int seq = item >> 2, ec = (item & 3) * 256 + threadIdx.x, dir = seq & 1;
        const int d0 = (ec * 8) & 63;
        float st[8];
#pragma unroll
        for (int j = 0; j < 8; ++j) st[j] = 0.f;
#pragma unroll 4
        for (int i = 0; i < 32; ++i) {
            const int c = dir ? 31 - i : i; const long u = (long)seq * 32 + c;
            u32x4* pp = (u32x4*)(UT + u * 8192 + ec * 8);
            const u32x4 v = *pp; const f32x4 da = *(const f32x4*)(DEC + u * 64 + d0), db = *(const f32x4*)(DEC + u * 64 + d0 + 4);
            u32x4 o; o[0] = pk2(st[0], st[1]); o[1] = pk2(st[2], st[3]); o[2] = pk2(st[4], st[5]); o[3] = pk2(st[6], st[7]);
            *pp = o;
#pragma unroll
            for (int j = 0; j < 4; ++j) { const float d0_ = j < 2 ? da[2 * (j & 1)] : db[2 * (j & 1)], d1_ = j < 2 ? da[2 * (j & 1) + 1] : db[2 * (j & 1) + 1];
                st[2 * j] = d0_ * st[2 * j] + __uint_as_float(v[j] << 16); st[2 * j + 1] = d1_ * st[2 * j + 1] + __uint_as_float(v[j] & 0xffff0000u); }
        }
    }
}
DI void ph_gla3(const Params& P, char* smem) {
    TILE_IDS
    const bf16_t* h = (const bf16_t*)(P.ws + OFF_A);
    const bf16_t* UT = (const bf16_t*)(P.ws + OFF_C);
    bf16_t* mix = (bf16_t*)(P.ws + OFF_D);
    float* s_cum = (float*)smem;
    bf16_t* QG = (bf16_t*)(smem + 22528); bf16_t* KG = (bf16_t*)(smem + 31744); bf16_t* Vt = (bf16_t*)(smem + 40960);
    for (int unit = blockIdx.x; unit < NB * 4 * 32; unit += gridDim.x) {
        const int c = unit & 31, hh = (unit >> 5) & 3, b = unit >> 7;
        const long tok0 = (long)b * S + c * 64;
        const bf16_t* hrow0 = h + tok0 * HE;
        gla_load_vt(hrow0, hh, smem);
        f32x4 oacc[8];
#pragma unroll
        for (int e = 0; e < 8; ++e) oacc[e] = (f32x4){0.f, 0.f, 0.f, 0.f};
        for (int dir = 0; dir < 2; ++dir) {
            u32x2 qraw[4], kraw[4]; bf16x8 sfr[8][2];
            { const int l = t >> 2, dc = (t & 3) * 16;
              const bf16_t* qp = hrow0 + (long)l * HE + H_GQ + hh * 64 + dc; const bf16_t* kp = hrow0 + (long)l * HE + H_GK + hh * 64 + dc;
#pragma unroll
              for (int q4 = 0; q4 < 4; ++q4) { qraw[q4] = *(const u32x2*)(qp + q4 * 4); kraw[q4] = *(const u32x2*)(kp + q4 * 4); } }
            { const bf16_t* sp0 = UT + (((long)(b * 4 + hh) * 2 + dir) * 32 + c) * 8192;
#pragma unroll
              for (int e = 0; e < 8; ++e)
#pragma unroll
                  for (int ks = 0; ks < 2; ++ks) sfr[e][ks] = *(const bf16x8*)(sp0 + (e * 16 + fr) * 64 + ks * 32 + fq * 8); }
            gla_cum(P, dir, hrow0, hh, smem);
            { const int l = t >> 2, dc = (t & 3) * 16;
#pragma unroll
              for (int q4 = 0; q4 < 4; ++q4) {
                  const f32x4 qv = {__uint_as_float(qraw[q4][0] << 16), __uint_as_float(qraw[q4][0] & 0xffff0000u), __uint_as_float(qraw[q4][1] << 16), __uint_as_float(qraw[q4][1] & 0xffff0000u)};
                  const f32x4 kv = {__uint_as_float(kraw[q4][0] << 16), __uint_as_float(kraw[q4][0] & 0xffff0000u), __uint_as_float(kraw[q4][1] << 16), __uint_as_float(kraw[q4][1] & 0xffff0000u)};
                  f32x4 qo, ko;
#pragma unroll
                  for (int j = 0; j < 4; ++j) { const float cm = s_cum[l * 64 + dc + q4 * 4 + j]; qo[j] = qv[j] * 0.125f * __expf(cm); ko[j] = kv[j] * __expf(-cm); }
                  st_bf4(QG + l * LDT + dc + q4 * 4, qo); st_bf4(KG + l * LDT + dc + q4 * 4, ko); } }
            __syncthreads();
            f32x4 att[4];
#pragma unroll
            for (int mt = 0; mt < 4; ++mt) att[mt] = (f32x4){0.f, 0.f, 0.f, 0.f};
            bf16x8 qf[2];
#pragma unroll
            for (int ks = 0; ks < 2; ++ks) qf[ks] = *(const bf16x8*)(QG + (wid * 16 + fr) * LDT + ks * 32 + fq * 8);
#pragma unroll
            for (int ks = 0; ks < 2; ++ks)
#pragma unroll
                for (int mt = 0; mt < 4; ++mt) { bf16x8 kf = *(const bf16x8*)(KG + (mt * 16 + fr) * LDT + ks * 32 + fq * 8); att[mt] = MFMA16(kf, qf[ks], att[mt]); }
            const int lrow = wid * 16 + fr;
#pragma unroll
            for (int mt = 0; mt < 4; ++mt)
#pragma unroll
                for (int j = 0; j < 4; ++j) { const int mm = mt * 16 + fq * 4 + j; const bool keep = dir == 0 ? (mm <= lrow) : (mm >= lrow); if (!keep) att[mt][j] = 0.f; }
            bf16x8 pb[2];
#pragma unroll
            for (int k2 = 0; k2 < 2; ++k2) { u32x4 w; w[0] = pk2(att[2 * k2][0], att[2 * k2][1]); w[1] = pk2(att[2 * k2][2], att[2 * k2][3]); w[2] = pk2(att[2 * k2 + 1][0], att[2 * k2 + 1][1]); w[3] = pk2(att[2 * k2 + 1][2], att[2 * k2 + 1][3]); pb[k2] = __builtin_bit_cast(bf16x8, w); }
#pragma unroll
            for (int e = 0; e < 8; ++e) {
#pragma unroll
                for (int k2 = 0; k2 < 2; ++k2) {
                    const s16x4 lo = *(const s16x4*)(Vt + (e * 16 + fr) * LDT + k2 * 32 + fq * 4), hi = *(const s16x4*)(Vt + (e * 16 + fr) * LDT + k2 * 32 + 16 + fq * 4);
                    const bf16x8 vf = __builtin_shufflevector(lo, hi, 0, 1, 2, 3, 4, 5, 6, 7);
                    oacc[e] = MFMA16(vf, pb[k2], oacc[e]);
                }
#pragma unroll
                for (int ks = 0; ks < 2; ++ks) oacc[e] = MFMA16(sfr[e][ks], qf[ks], oacc[e]);
            }
            __syncthreads();
        }
        float ss = 0.f;
#pragma unroll
        for (int e = 0; e < 8; ++e)
#pragma unroll
            for (int j = 0; j < 4; ++j) ss += oacc[e][j] * oacc[e][j];
        ss += __shfl_xor(ss, 16); ss += __shfl_xor(ss, 32);
        const float rinv = rsqrtf(ss * (1.f / 128.f) + EPS);
        const long tok = tok0 + wid * 16 + fr;
#pragma unroll
        for (int e = 0; e < 8; ++e) {
            const int ee = e * 16 + fq * 4;
            const f32x4 gr = ld_bf4(h + tok * HE + H_GR + hh * 128 + ee); const f32x4 gn = *(const f32x4*)(P.gla_norm + ee); f32x4 o;
#pragma unroll
            for (int j = 0; j < 4; ++j) { const float g = gr[j]; o[j] = oacc[e][j] * rinv * gn[j] * (g / (1.f + __expf(-g))); }
            st_bf4(mix + tok * 1024 + 512 + hh * 128 + ee, o);
        }
    }
}

template <int DQK>
DI void attn_unit(const bf16_t* Q, int q_ss, const bf16_t* K, int k_ss, const bf16_t* V, int v_ss, bf16_t* O, char* smem) {
    TILE_IDS
    constexpr int KS = DQK / 32, CPR = DQK / 8, ROWB = DQK * 2, KBYTES = 64 * ROWB, NKP = KBYTES / 1024 / 4  , ASTG = KBYTES + 8192;
    constexpr int QT = DQK == 64 ? 4 : 2;
    bf16x8 qf[QT][KS];
#pragma unroll
    for (int qt = 0; qt < QT; ++qt)
#pragma unroll
        for (int ks = 0; ks < KS; ++ks) qf[qt][ks] = *(const bf16x8*)(Q + (long)(wid * (QT * 16) + qt * 16 + fr) * q_ss + ks * 32 + fq * 8);
    f32x4 oacc[4][QT];
#pragma unroll
    for (int dt = 0; dt < 4; ++dt)
#pragma unroll
        for (int qt = 0; qt < QT; ++qt) oacc[dt][qt] = (f32x4){0.f, 0.f, 0.f, 0.f};
    float mrun[QT], lrun[QT];
#pragma unroll
    for (int qt = 0; qt < QT; ++qt) { mrun[qt] = 0.f; lrun[qt] = 0.f; }
    unsigned ko[NKP], vo[2];
#pragma unroll
    for (int i = 0; i < NKP; ++i) {
        const int q = (wid * NKP + i) * 64 + lane, row = q / CPR, pc = q % CPR;
        const int cc = DQK == 96 ? ((pc & ~3) | ((pc & 3) ^ (((row >> 3) & 1) << 1))) : (pc ^ ((row >> 1) & 7));
        ko[i] = (unsigned)((row * k_ss + cc * 8) * 2);
    }
#pragma unroll
    for (int i = 0; i < 2; ++i) {
        const int q = (wid * 2 + i) * 64 + lane, row = q >> 3, pc = q & 7, cc = pc ^ (((row >> 1) & 3) << 1);
        vo[i] = (unsigned)((row * v_ss + cc * 8) * 2);
    }
    const char* Kb = (const char*)K; const char* Vb = (const char*)V;
    const unsigned kstep = (unsigned)(64 * k_ss * 2), vstep = (unsigned)(64 * v_ss * 2);
#define ALDS(kt_, st_) { \
        _Pragma("unroll") for (int i = 0; i < NKP; ++i) __builtin_amdgcn_global_load_lds((const unsigned*)(Kb + (ko[i] + (unsigned)(kt_) * kstep)), (LAS3 unsigned*)(smem + (st_) * ASTG + (wid * NKP + i) * 1024), 16, 0, 0); \
        _Pragma("unroll") for (int i = 0; i < 2; ++i) __builtin_amdgcn_global_load_lds((const unsigned*)(Vb + (vo[i] + (unsigned)(kt_) * vstep)), (LAS3 unsigned*)(smem + (st_) * ASTG + KBYTES + (wid * 2 + i) * 1024), 16, 0, 0); }
    const int kpc96 = fq ^ (((fr >> 3) & 1) << 1), ksw64 = (fr >> 1) & 7;
    const int vq = fr >> 2, vp = fr & 3, vsw = ((2 * fq + (vq >> 1)) & 3) << 1;
    ALDS(0, 0)
    ALDS(1, 1)
    int sc = 0, sl = 2;
    for (int kt = 0; kt < S / 64; ++kt) {
        if (kt + 1 < S / 64) { if (NKP == 3) asm volatile("s_waitcnt vmcnt(5)" ::: "memory"); else asm volatile("s_waitcnt vmcnt(4)" ::: "memory"); }
        else asm volatile("s_waitcnt vmcnt(0)" ::: "memory");
        __builtin_amdgcn_s_barrier();
        asm volatile("" ::: "memory");
        if (kt + 2 < S / 64) ALDS(kt + 2, sl)
        const char* Ks = smem + sc * ASTG; const char* Vs = Ks + KBYTES;
        f32x4 st[4][QT];
#pragma unroll
        for (int mt = 0; mt < 4; ++mt)
#pragma unroll
            for (int qt = 0; qt < QT; ++qt) { const float nm = -mrun[qt]; st[mt][qt] = (f32x4){nm, nm, nm, nm}; }
#pragma unroll
        for (int ks = 0; ks < KS; ++ks)
#pragma unroll
            for (int mt = 0; mt < 4; ++mt) {
                const int pc = DQK == 96 ? (4 * ks + kpc96) : ((4 * ks + fq) ^ ksw64);
                const bf16x8 kf = *(const bf16x8*)(Ks + (mt * 16 + fr) * ROWB + pc * 16);
#pragma unroll
                for (int qt = 0; qt < QT; ++qt) st[mt][qt] = MFMA16(kf, qf[qt][ks], st[mt][qt]);
            }
        bf16x8 pb[QT][2];
#pragma unroll
        for (int qt = 0; qt < QT; ++qt) {
            float mx = st[0][qt][0];
#pragma unroll
            for (int mt = 0; mt < 4; ++mt)
#pragma unroll
                for (int j = 0; j < 4; ++j) mx = fmaxf(mx, st[mt][qt][j]);
            mx = fmaxf(mx, __shfl_xor(mx, 16)); mx = fmaxf(mx, __shfl_xor(mx, 32));
            if (kt == 0) {
                mrun[qt] = mx;
#pragma unroll
                for (int mt = 0; mt < 4; ++mt) st[mt][qt] = st[mt][qt] - mx;
            } else {
                const bool need = mx > 8.f;
                if (__any(need)) {
                    const float delta = need ? mx : 0.f, alpha = __builtin_amdgcn_exp2f(-delta);
                    mrun[qt] += delta; lrun[qt] *= alpha;
#pragma unroll
                    for (int mt = 0; mt < 4; ++mt) st[mt][qt] = st[mt][qt] - delta;
#pragma unroll
                    for (int dt = 0; dt < 4; ++dt) oacc[dt][qt] *= alpha;
                }
            }
            float rsum = 0.f;
#pragma unroll
            for (int mt = 0; mt < 4; ++mt)
#pragma unroll
                for (int j = 0; j < 4; ++j) { const float pv = __builtin_amdgcn_exp2f(st[mt][qt][j]); st[mt][qt][j] = pv; rsum += pv; }
            lrun[qt] += rsum;
#pragma unroll
            for (int k2 = 0; k2 < 2; ++k2) { u32x4 w; w[0] = pk2(st[2 * k2][qt][0], st[2 * k2][qt][1]); w[1] = pk2(st[2 * k2][qt][2], st[2 * k2][qt][3]); w[2] = pk2(st[2 * k2 + 1][qt][0], st[2 * k2 + 1][qt][1]); w[3] = pk2(st[2 * k2 + 1][qt][2], st[2 * k2 + 1][qt][3]); pb[qt][k2] = __builtin_bit_cast(bf16x8, w); }
        }
#pragma unroll
        for (int dt = 0; dt < 4; ++dt)
#pragma unroll
            for (int k2 = 0; k2 < 2; ++k2) {
                const int pcv = (4 * (dt >> 1) + vp) ^ vsw;
                const char* base = Vs + (k2 * 32 + 4 * fq + vq) * 128 + pcv * 16 + (dt & 1) * 8;
                const s16x4 lo = __builtin_amdgcn_ds_read_tr16_b64_v4i16((LAS3 s16x4*)(base));
                const s16x4 hi = __builtin_amdgcn_ds_read_tr16_b64_v4i16((LAS3 s16x4*)(base + 16 * 128));
                const bf16x8 vf = __builtin_shufflevector(lo, hi, 0, 1, 2, 3, 4, 5, 6, 7);
#pragma unroll
                for (int qt = 0; qt < QT; ++qt) oacc[dt][qt] = MFMA16(vf, pb[qt][k2], oacc[dt][qt]);
            }
        sc = sc == 2 ? 0 : sc + 1; sl = sl == 2 ? 0 : sl + 1;
    }
    __syncthreads();
#pragma unroll
    for (int qt = 0; qt < QT; ++qt) {
        float l = lrun[qt]; l += __shfl_xor(l, 16); l += __shfl_xor(l, 32);
        const float inv = 1.f / l;
#pragma unroll
        for (int p2 = 0; p2 < 2; ++p2) st_bf8(O + (long)(wid * (QT * 16) + qt * 16 + fr) * 1024 + p2 * 32 + fq * 8, oacc[2 * p2][qt] * inv, oacc[2 * p2 + 1][qt] * inv);
    }
}
DI void ph_attn_mla(const Params& P, char* smem) {
    const bf16_t* Qm = (const bf16_t*)(P.ws + OFF_B); const bf16_t* Kc = (const bf16_t*)(P.ws + OFF_B + 48 * MiB); const bf16_t* Vm = (const bf16_t*)(P.ws + OFF_B + 96 * MiB);
    bf16_t* mix = (bf16_t*)(P.ws + OFF_D);
    for (int blk, sl; xcd_pop(P, 8, 32, blk, sl, smem); ) {
        const int pair = blk * 4 + (sl >> 4), qb = sl & 15, hd = pair & 7, b = pair >> 3;
        const long tq = (long)b * S + qb * 128, tk = (long)b * S;
        attn_unit<96>(Qm + tq * 768 + hd * 96, 768, Kc + tk * 768 + hd * 96, 768, Vm + tk * 512 + hd * 64, 512, mix + tq * 1024 + hd * 64, smem);
    }
}
DI void ph_attn_gqa(const Params& P, char* smem) {
    const bf16_t* qkv = (const bf16_t*)(P.ws + OFF_A);
    bf16_t* mix = (bf16_t*)(P.ws + OFF_D);
    for (int blk, sl; xcd_pop(P, 9, 32, blk, sl, smem); ) {
        const int grp = blk * 2 + (sl >> 5), qb = sl & 7, b = grp >> 2, kv = grp & 3, hd = kv * 4 + ((sl >> 3) & 3);
        const long tq = (long)b * S + qb * 256, tk = (long)b * S;
        attn_unit<64>(qkv + tq * 1536 + hd * 64, 1536, qkv + tk * 1536 + 1024 + kv * 64, 1536, qkv + tk * 1536 + 1280 + kv * 64, 1536, mix + tq * 1024 + hd * 64, smem);
    }
}

DI void ph_wo(const Params& P, int layer, char* smem) {
    const bf16_t* mix = (const bf16_t*)(P.ws + OFF_D);
    const bf16_t* x2h = (const bf16_t*)(P.ws + OFF_B);
    float* pre1 = (float*)(P.ws + OFF_A);
    const bf16_t* Wt = (const bf16_t*)(P.ws + OFF_WS) + W_O + (long)layer * 1048576;
    for (int blk, sl; xcd_pop(P, 1 + layer, 16, blk, sl, smem); ) {
        TILE_IDS
        const int mt = blk * 8 + (sl >> 3), nt = sl & 7;
        GP g{mix, 1024, nullptr, mt * 256, Wt, 1024, nt * 128, 1024, 1024, 1};
        f32x4 acc[8][4]; zero_acc(acc);
        gemm_main(g, acc, smem);
#pragma unroll
        for (int m = 0; m < 8; ++m) {
            const long row = mt * 256 + wr * 128 + m * 16 + fr;
#pragma unroll
            for (int np = 0; np < 2; ++np) {
                const int col = nt * 128 + wc * 64 + np * 32 + fq * 8;
                f32x4 xv0, xv1;
                if (layer == 0) { xv0 = *(const f32x4*)(P.x + row * 1024 + col); xv1 = *(const f32x4*)(P.x + row * 1024 + col + 4); }
                else { const u32x4 w = *(const u32x4*)(x2h + row * 1024 + col);
                       xv0 = (f32x4){__uint_as_float(w[0] << 16), __uint_as_float(w[0] & 0xffff0000u), __uint_as_float(w[1] << 16), __uint_as_float(w[1] & 0xffff0000u)};
                       xv1 = (f32x4){__uint_as_float(w[2] << 16), __uint_as_float(w[2] & 0xffff0000u), __uint_as_float(w[3] << 16), __uint_as_float(w[3] & 0xffff0000u)}; }
                *(f32x4*)(pre1 + row * 1024 + col) = xv0 * ALPHA + acc[m][2 * np];
                *(f32x4*)(pre1 + row * 1024 + col + 4) = xv1 * ALPHA + acc[m][2 * np + 1];
            }
        }
    }
}

DI void ph_ln1_router(const Params& P, int layer, char* smem) {
    const int t = threadIdx.x, lane = t & 63, wid = t >> 6;
    float* rwT = (float*)smem;
    const float* rw = P.router_w + (long)layer * 1024 * 16;
    for (int i = t; i < 16384; i += NTHR) { const int k = i >> 4, e = i & 15; rwT[e * 1024 + k] = rw[i]; }
    __syncthreads();
    const float* pre1 = (const float*)(P.ws + OFF_A); bf16_t* x1h = (bf16_t*)(P.ws + OFF_B); float* aff = (float*)(P.ws + OFF_MISC + M_AFF);
    const float* g = P.ln1_g + layer * 1024; const float* bb = P.ln1_b + layer * 1024;
    for (long row = (long)blockIdx.x * 4 + wid; row < T; row += (long)gridDim.x * 4) {
        f32x4 v[4]; float s = 0.f;
#pragma unroll
        for (int i = 0; i < 4; ++i) { v[i] = *(const f32x4*)(pre1 + row * 1024 + i * 256 + lane * 4); s += (v[i][0] + v[i][1]) + (v[i][2] + v[i][3]); }
        const float mean = wave_sum(s) * (1.f / 1024.f);
        float q = 0.f;
#pragma unroll
        for (int i = 0; i < 4; ++i) { v[i] = v[i] - mean; q += (v[i][0] * v[i][0] + v[i][1] * v[i][1]) + (v[i][2] * v[i][2] + v[i][3] * v[i][3]); }
        const float rstd = rsqrtf(wave_sum(q) * (1.f / 1024.f) + EPS);
#pragma unroll
        for (int i = 0; i < 4; ++i) { const f32x4 gg = *(const f32x4*)(g + i * 256 + lane * 4), bv = *(const f32x4*)(bb + i * 256 + lane * 4); v[i] = v[i] * rstd * gg + bv; const long o_ = row * 1024 + i * 256 + lane * 4; st_bf4(x1h + o_, v[i]); }
        float p[16];
#pragma unroll
        for (int e = 0; e < 16; ++e) {
            float a = 0.f;
#pragma unroll
            for (int i = 0; i < 4; ++i) { const f32x4 w = *(const f32x4*)(rwT + e * 1024 + i * 256 + lane * 4); a += (v[i][0] * w[0] + v[i][1] * w[1]) + (v[i][2] * w[2] + v[i][3] * w[3]); }
            p[e] = a;
            if ((e & 3) == 3) __builtin_amdgcn_sched_barrier(0);
        }
        const bool h5 = lane & 32, h4 = lane & 16, h3 = lane & 8, h2 = lane & 4;
        float r8[8], r4[4], r2[2];
#pragma unroll
        for (int e = 0; e < 8; ++e) { const float keep = h5 ? p[e + 8] : p[e], send = h5 ? p[e] : p[e + 8]; r8[e] = keep + __shfl_xor(send, 32); }
#pragma unroll
        for (int e = 0; e < 4; ++e) { const float keep = h4 ? r8[e + 4] : r8[e], send = h4 ? r8[e] : r8[e + 4]; r4[e] = keep + __shfl_xor(send, 16); }
#pragma unroll
        for (int e = 0; e < 2; ++e) { const float keep = h3 ? r4[e + 2] : r4[e], send = h3 ? r4[e] : r4[e + 2]; r2[e] = keep + __shfl_xor(send, 8); }
        float mylg; { const float keep = h2 ? r2[1] : r2[0], send = h2 ? r2[0] : r2[1]; mylg = keep + __shfl_xor(send, 4); }
        mylg += __shfl_xor(mylg, 2); mylg += __shfl_xor(mylg, 1);
        float mx = mylg;
        mx = fmaxf(mx, __shfl_xor(mx, 32)); mx = fmaxf(mx, __shfl_xor(mx, 16)); mx = fmaxf(mx, __shfl_xor(mx, 8)); mx = fmaxf(mx, __shfl_xor(mx, 4));
        const float ex = expf(mylg - mx);
        float den = ex;
        den += __shfl_xor(den, 32); den += __shfl_xor(den, 16); den += __shfl_xor(den, 8); den += __shfl_xor(den, 4);
        const float mine = ex / den;
        const int myE = (h5 ? 8 : 0) + (h4 ? 4 : 0) + (h3 ? 2 : 0) + (h2 ? 1 : 0);
        if ((lane & 3) == 0) { const long b = row >> 11, sp = row & (S - 1); aff[(b * 16 + myE) * S + sp] = mine; }
    }
    __syncthreads();
}

DI void ph_topk(const Params& P, char* smem) {
    const int t = threadIdx.x;
    unsigned long long* key = (unsigned long long*)smem;
    const float* aff = (const float*)(P.ws + OFF_MISC + M_AFF);
    int* seli = (int*)(P.ws + OFF_MISC + M_SELI); float* selg = (float*)(P.ws + OFF_MISC + M_SELG); int* inv = (int*)(P.ws + OFF_MISC + M_INV);
    for (int unit = blockIdx.x; unit < NB * 16; unit += gridDim.x) {
        const int b = unit >> 4, e = unit & 15;
        for (int i = t; i < S; i += NTHR) key[i] = ((unsigned long long)__float_as_uint(aff[(long)unit * S + i]) << 32) | (unsigned)(S - 1 - i);
        __syncthreads();
        const int qbase = (t >> 6) * 256 + (t & 63);
        for (int k = 2; k <= S; k <<= 1)
            for (int j = k >> 1; j > 0; j >>= 1) {
#pragma unroll
                for (int r = 0; r < 4; ++r) {
                    const int q = qbase + 64 * r;
                    const int i = ((q & ~(j - 1)) << 1) | (q & (j - 1)), l = i | j;
                    const unsigned long long a = key[i], c = key[l];
                    const bool desc = (i & k) == 0;
                    if (desc ? (a < c) : (a > c)) { key[i] = c; key[l] = a; }
                }
                if (j >= 512 || (j == 1 && k >= 512)) __syncthreads();
                else asm volatile("s_waitcnt lgkmcnt(0)" ::: "memory");
            }
        __syncthreads();
        for (int i = t; i < S; i += NTHR) {
            const unsigned long long kk = key[i]; const int idx = S - 1 - (int)(unsigned)(kk & 0xffffffffu);
            if (i < 256) { seli[unit * 256 + i] = b * S + idx; selg[unit * 256 + i] = __uint_as_float((unsigned)(kk >> 32)); }
            inv[((long)b * S + idx) * 16 + e] = i < 256 ? i : -1;
        }
        __syncthreads();
    }
}
DI void ph_ple(const Params& P, int layer, char* smem) {
    const bf16_t* x1h = (const bf16_t*)(P.ws + OFF_B); const bf16_t* pb = (const bf16_t*)(P.ws + OFF_P) + (long)layer * T * 256;
    bf16_t* ple = (bf16_t*)(P.ws + OFF_A);
    const bf16_t* Wg = (const bf16_t*)(P.ws + OFF_WS) + W_PG + (long)layer * 1048576;
    const bf16_t* Wp = (const bf16_t*)(P.ws + OFF_WS) + W_PW + (long)layer * 262144;
    const float* bg = P.pg_b + layer * 1024;
    for (int blk, sl; xcd_pop(P, 10 + layer, 16, blk, sl, smem); ) {
        TILE_IDS
        const int mt = blk * 8 + (sl >> 3), nt = sl & 7;
        f32x4 acc[8][4]; zero_acc(acc);
        { GP g{pb, 256, nullptr, mt * 256, Wp, 256, nt * 128, 1024, 256, 1}; gemm_main(g, acc, smem); }
#pragma unroll
        for (int m = 0; m < 8; ++m)
#pragma unroll
            for (int np = 0; np < 2; ++np) st_bf8(ple + (long)(mt * 256 + wr * 128 + m * 16 + fr) * 1024 + nt * 128 + wc * 64 + np * 32 + fq * 8, acc[m][2 * np], acc[m][2 * np + 1]);
        zero_acc(acc);
        { GP g{x1h, 1024, nullptr, mt * 256, Wg, 1024, nt * 128, 1024, 1024, 1}; gemm_main(g, acc, smem); }
#pragma unroll
        for (int m = 0; m < 8; ++m) {
            const long row = mt * 256 + wr * 128 + m * 16 + fr;
#pragma unroll
            for (int np = 0; np < 2; ++np) {
                const int col = nt * 128 + wc * 64 + np * 32 + fq * 8;
                const u32x4 lw = *(const u32x4*)(ple + row * 1024 + col);
                f32x4 o[2];
#pragma unroll
                for (int h2 = 0; h2 < 2; ++h2) {
                    const f32x4 bv = *(const f32x4*)(bg + col + 4 * h2);
                    const f32x4 l4 = {__uint_as_float(lw[2 * h2] << 16), __uint_as_float(lw[2 * h2] & 0xffff0000u), __uint_as_float(lw[2 * h2 + 1] << 16), __uint_as_float(lw[2 * h2 + 1] & 0xffff0000u)};
#pragma unroll
                    for (int j = 0; j < 4; ++j) o[h2][j] = l4[j] / (1.f + __expf(-(acc[m][2 * np + h2][j] + bv[j])));
                }
                st_bf8(ple + row * 1024 + col, o[0], o[1]);
            }
        }
    }
}
DI void ph_moe1(const Params& P, char* smem, int layer_) {
    const bf16_t* x1h = (const bf16_t*)(P.ws + OFF_B); const int* seli = (const int*)(P.ws + OFF_MISC + M_SELI);
    const bf16_t* w13 = (const bf16_t*)(P.ws + OFF_WMOE);
    bf16_t* hid = (bf16_t*)(P.ws + OFF_C);
    for (int blk, sl; xcd_pop(P, 3 + layer_, 64, blk, sl, smem); ) {
        TILE_IDS
        const int nt = sl & 15, b = (blk & 3) * 4 + (sl >> 4), e = blk >> 2, grp = b * 16 + e;
        GP g{x1h, 1024, seli + grp * 256, 0, w13 + (long)e * 2048 * 1024, 1024, nt * 128, 2048, 1024, 1};
        f32x4 acc[8][4]; zero_acc(acc);
        gemm_main(g, acc, smem);
#pragma unroll
        for (int m = 0; m < 8; ++m) {
            const long row = (long)grp * 256 + wr * 128 + m * 16 + fr;
            { f32x4 o[2];
#pragma unroll
              for (int n = 0; n < 2; ++n)
#pragma unroll
                  for (int j = 0; j < 4; ++j) { const float a = acc[m][n][j]; o[n][j] = a / (1.f + __expf(-a)) * acc[m][n + 2][j]; }
              st_bf8(hid + row * 1024 + nt * 64 + wc * 32 + fq * 8, o[0], o[1]); }
        }
    }
}
DI void ph_moe2(const Params& P, char* smem, int layer_) {
    const bf16_t* hid = (const bf16_t*)(P.ws + OFF_C);
    const bf16_t* w2t = (const bf16_t*)(P.ws + OFF_WMOE) + 16L * 2048 * 1024;
    bf16_t* ye = (bf16_t*)(P.ws + OFF_A + 64 * MiB);
    for (int blk, sl; xcd_pop(P, 5 + layer_, 32, blk, sl, smem); ) {
        TILE_IDS
        const int nt = sl & 7, b = (blk & 1) * 8 + (sl >> 3), e = blk >> 1, grp = b * 16 + e;
        GP g{hid + (long)grp * 256 * 1024, 1024, nullptr, 0, w2t + (long)e * 1024 * 1024, 1024, nt * 128, 1024, 1024, 1};
        f32x4 acc[8][4]; zero_acc(acc);
        gemm_main(g, acc, smem);
#pragma unroll
        for (int m = 0; m < 8; ++m) {
            const long row = (long)grp * 256 + wr * 128 + m * 16 + fr;
#pragma unroll
            for (int np = 0; np < 2; ++np) st_bf8(ye + row * 1024 + nt * 128 + wc * 64 + np * 32 + fq * 8, acc[m][2 * np], acc[m][2 * np + 1]);
        }
    }
}
DI void ph_ln2(const Params& P, int layer) {
    const int t = opaque_tid(), lane = t & 63, wid = t >> 6;
    bf16_t* x1h = (bf16_t*)(P.ws + OFF_B); const bf16_t* ple = (const bf16_t*)(P.ws + OFF_A); const bf16_t* ye = (const bf16_t*)(P.ws + OFF_A + 64 * MiB);
    const int* inv = (const int*)(P.ws + OFF_MISC + M_INV); const float* selg = (const float*)(P.ws + OFF_MISC + M_SELG);
    const float* g = P.ln2_g + layer * 1024; const float* bb = P.ln2_b + layer * 1024;
    for (long row0 = ((long)blockIdx.x * 4 + wid) * 2; row0 < T; row0 += (long)gridDim.x * 8) {
        const int b = (int)(row0 >> 11);
        f32x4 v[2][4]; int slotl[2]; u32x2 xr[2][4], pr[2][4];
#pragma unroll
        for (int r = 0; r < 2; ++r) {
            const long row = row0 + r;
            slotl[r] = lane < 16 ? inv[row * 16 + lane] : -1;
#pragma unroll
            for (int i = 0; i < 4; ++i) { const int col = i * 256 + lane * 4; xr[r][i] = *(const u32x2*)(x1h + row * 1024 + col); pr[r][i] = *(const u32x2*)(ple + row * 1024 + col); }
        }
        unsigned long long mask[2]; int nh[2]; u32x2 raw[2][4][4]; float gate[2][4];
#pragma unroll
        for (int r = 0; r < 2; ++r) {
            mask[r] = __ballot(slotl[r] >= 0); nh[r] = __popcll(mask[r]);
            unsigned long long m = mask[r];
#pragma unroll
            for (int k = 0; k < 4; ++k) {
                gate[r][k] = 0.f;
#pragma unroll
                for (int i = 0; i < 4; ++i) raw[r][k][i] = (u32x2){0u, 0u};
                if (k < nh[r]) {
                    const int e = __ffsll((long long)m) - 1; m &= m - 1;
                    const int slot = __builtin_amdgcn_readlane(slotl[r], e);
                    const long gr = (long)(b * 16 + e) * 256 + slot;
                    gate[r][k] = selg[gr];
#pragma unroll
                    for (int i = 0; i < 4; ++i) raw[r][k][i] = *(const u32x2*)(ye + gr * 1024 + i * 256 + lane * 4);
                }
            }
            mask[r] = m;
        }
#pragma unroll
        for (int r = 0; r < 2; ++r) {
            const long row = row0 + r;
#pragma unroll
            for (int i = 0; i < 4; ++i) {
                const f32x4 xv = {__uint_as_float(xr[r][i][0] << 16), __uint_as_float(xr[r][i][0] & 0xffff0000u), __uint_as_float(xr[r][i][1] << 16), __uint_as_float(xr[r][i][1] & 0xffff0000u)};
                const f32x4 pv = {__uint_as_float(pr[r][i][0] << 16), __uint_as_float(pr[r][i][0] & 0xffff0000u), __uint_as_float(pr[r][i][1] << 16), __uint_as_float(pr[r][i][1] & 0xffff0000u)};
                v[r][i] = xv * ALPHA + pv;
            }
#pragma unroll
            for (int k = 0; k < 4; ++k)
#pragma unroll
                for (int i = 0; i < 4; ++i) {
                    const f32x4 yv = {__uint_as_float(raw[r][k][i][0] << 16), __uint_as_float(raw[r][k][i][0] & 0xffff0000u), __uint_as_float(raw[r][k][i][1] << 16), __uint_as_float(raw[r][k][i][1] & 0xffff0000u)};
                    v[r][i] = v[r][i] + yv * gate[r][k];
                }
            unsigned long long m = mask[r];
            while (m) {
                const int e = __ffsll((long long)m) - 1; m &= m - 1;
                const int slot = __builtin_amdgcn_readlane(slotl[r], e);
                const long gr = (long)(b * 16 + e) * 256 + slot; const float gt = selg[gr];
#pragma unroll
                for (int i = 0; i < 4; ++i) v[r][i] = v[r][i] + ld_bf4(ye + gr * 1024 + i * 256 + lane * 4) * gt;
            }
            float s = 0.f;
#pragma unroll
            for (int i = 0; i < 4; ++i) s += (v[r][i][0] + v[r][i][1]) + (v[r][i][2] + v[r][i][3]);
            const float mean = wave_sum(s) * (1.f / 1024.f);
            float q = 0.f;
#pragma unroll
            for (int i = 0; i < 4; ++i) { v[r][i] = v[r][i] - mean; q += (v[r][i][0] * v[r][i][0] + v[r][i][1] * v[r][i][1]) + (v[r][i][2] * v[r][i][2] + v[r][i][3] * v[r][i][3]); }
            const float rstd = rsqrtf(wave_sum(q) * (1.f / 1024.f) + EPS);
#pragma unroll
            for (int i = 0; i < 4; ++i) { const int col = i * 256 + lane * 4; const f32x4 gg = *(const f32x4*)(g + col), bv = *(const f32x4*)(bb + col); const f32x4 y = v[r][i] * rstd * gg + bv; if (layer == 1) *(f32x4*)(P.out + row * 1024 + col) = y; else st_bf4(x1h + row * 1024 + col, y); }
        }
    }
}
DI void ph_win_odd(const Params& P, char* smem) {
    const bf16_t* x2h = (const bf16_t*)(P.ws + OFF_B);
    bf16_t* qkv = (bf16_t*)(P.ws + OFF_A);
    const bf16_t* Wt = (const bf16_t*)(P.ws + OFF_WS) + W_INO;
    const float* ropeC = (const float*)(P.ws + OFF_MISC + M_ROPEC);
    const float qscale = 0.125f * LOG2E;
    for (int blk, sl; xcd_pop(P, 7, 24, blk, sl, smem); ) {
        TILE_IDS
        const int mt = (blk / 3) * 16 + (sl >> 2), nt = (blk % 3) * 4 + (sl & 3);
        GP g{x2h, 1024, nullptr, mt * 256, Wt, 1024, nt * 128, 1536, 1024, 1};
        f32x4 acc[8][4]; zero_acc(acc);
        gemm_main(g, acc, smem);
        const int colw = nt * 128 + wc * 64;
        const int kind = colw < 1024 ? 0 : (colw < 1280 ? 1 : 2);
        const float* gn = kind == 0 ? P.gqa_q_norm : P.gqa_k_norm;
#pragma unroll
        for (int m = 0; m < 8; ++m) {
            const long row = mt * 256 + wr * 128 + m * 16 + fr; const int spos = (int)(row & (S - 1));
            bf16_t* dst = qkv + row * 1536 + colw + fq * 8;
            if (kind == 2) {
#pragma unroll
                for (int np = 0; np < 2; ++np) st_bf8(dst + np * 32, acc[m][2 * np], acc[m][2 * np + 1]);
            } else {
                float ss = 0.f;
#pragma unroll
                for (int n = 0; n < 4; ++n)
#pragma unroll
                    for (int j = 0; j < 4; ++j) ss += acc[m][n][j] * acc[m][n][j];
                ss += __shfl_xor(ss, 16); ss += __shfl_xor(ss, 32);
                const float rinv = rsqrtf(ss * (1.f / 64.f) + EPS) * (kind == 0 ? qscale : 1.f);
                f32x4 y[4];
#pragma unroll
                for (int n = 0; n < 4; ++n) { const f32x4 gg = *(const f32x4*)(gn + 32 * (n >> 1) + fq * 8 + 4 * (n & 1)); y[n] = acc[m][n] * rinv * gg; }
                f32x4 o1[2], o2[2];
#pragma unroll
                for (int n = 0; n < 2; ++n) {
                    const f32x4 c = *(const f32x4*)(ropeC + spos * 64 + fq * 8 + 4 * n), s = *(const f32x4*)(ropeC + spos * 64 + 32 + fq * 8 + 4 * n);
                    o1[n] = y[n] * c - y[n + 2] * s; o2[n] = y[n] * s + y[n + 2] * c;
                }
                st_bf8(dst, o1[0], o1[1]); st_bf8(dst + 32, o2[0], o2[1]);
            }
        }
    }
}

DI void ph_prologue(const Params& P, char* smem) {
    float* tile = (float*)smem;
    bf16_t* W = (bf16_t*)(P.ws + OFF_WS);
    conv_T(P.w_in_even, W + W_INE, 1, 1024, HE, 0, nullptr, 0, tile, (int)blockIdx.x, (int)gridDim.x);
    conv_T(P.w_uq, W + W_UQ, 1, 256, 768, 0, P.mla_q_norm, 0, tile, (int)blockIdx.x, (int)gridDim.x);
    conv_T(P.w_ukv, W + W_UKV, 1, 128, 1024, 0, P.mla_kv_norm, 0, tile, (int)blockIdx.x, (int)gridDim.x);
    conv_T(P.w_in_odd, W + W_INO, 1, 1024, 1536, 0, nullptr, 0, tile, (int)blockIdx.x, (int)gridDim.x);
    conv_T(P.w_o, W + W_O, 2, 1024, 1024, 1048576, nullptr, 0, tile, (int)blockIdx.x, (int)gridDim.x);
    conv_T(P.pg_w, W + W_PG, 2, 1024, 1024, 1048576, nullptr, 0, tile, (int)blockIdx.x, (int)gridDim.x);
    conv_T(P.ple_w, W + W_PW, 2, 256, 1024, 262144, nullptr, 0, tile, (int)blockIdx.x, (int)gridDim.x);
    { bf16_t* xb = (bf16_t*)(P.ws + OFF_C); bf16_t* pb = (bf16_t*)(P.ws + OFF_P);
      for (long i = ((long)blockIdx.x * NTHR + threadIdx.x) * 8; i < (long)T * 1024; i += (long)gridDim.x * NTHR * 8) {
          const f32x4 a = *(const f32x4*)(P.x + i), b = *(const f32x4*)(P.x + i + 4); u32x4 w = {pk2(a[0], a[1]), pk2(a[2], a[3]), pk2(b[0], b[1]), pk2(b[2], b[3])}; *(u32x4*)(xb + i) = w; }
      for (long i = ((long)blockIdx.x * NTHR + threadIdx.x) * 8; i < 2L * T * 256; i += (long)gridDim.x * NTHR * 8) {
          const f32x4 a = *(const f32x4*)(P.p + i), b = *(const f32x4*)(P.p + i + 4); u32x4 w = {pk2(a[0], a[1]), pk2(a[2], a[3]), pk2(b[0], b[1]), pk2(b[2], b[3])}; *(u32x4*)(pb + i) = w; } }
    float* ropeA = (float*)(P.ws + OFF_MISC + M_ROPEA); float* ropeC = (float*)(P.ws + OFF_MISC + M_ROPEC);
    for (int i = blockIdx.x * NTHR + threadIdx.x; i < S * 16; i += gridDim.x * NTHR) {
        const int s = i >> 4, k = i & 15; const int f = k & 7;
        const float invf = powf(10000.f, -(float)(2 * f) / 16.f);
        const float ang = (float)(k < 8 ? (s >> 6) : (s & 63)) * invf;
        ropeA[s * 32 + k] = cosf(ang); ropeA[s * 32 + 16 + k] = sinf(ang);
    }
    for (int i = blockIdx.x * NTHR + threadIdx.x; i < S * 32; i += gridDim.x * NTHR) {
        const int s = i >> 5, k = i & 31; const int f = k & 15;
        const float invf = powf(10000.f, -(float)(2 * f) / 32.f);
        const float ang = (float)(k < 16 ? (s >> 6) : (s & 63)) * invf;
        ropeC[s * 64 + k] = cosf(ang); ropeC[s * 64 + 32 + k] = sinf(ang);
    }
}

#define XB_TMO      128
#define XB_XCNT(j)  (256  + 64 * (j))
#define XB_XSUB(j)  (1280 + 64 * (j))
#define XB_XGEN(j)  (2304 + 64 * (j))
#define XB_TOP      3328
#define XB_TOPGEN   3392
#define XCD_BAR_WORDS 3456
#define XB_SPIN_CAP (1u << 22)
#define LAS __attribute__((address_space(3)))

__device__ __forceinline__ unsigned xb_ld(unsigned* p)              { return __hip_atomic_load(p, __ATOMIC_RELAXED, __HIP_MEMORY_SCOPE_AGENT); }
__device__ __forceinline__ unsigned xb_add(unsigned* p, unsigned v) { return __hip_atomic_fetch_add(p, v, __ATOMIC_RELAXED, __HIP_MEMORY_SCOPE_AGENT); }
__device__ __forceinline__ unsigned xb_xcc_id() { return (unsigned)__builtin_amdgcn_s_getreg((3 << 11) | 20) & 0xFu; }
#define XB_SPIN(cond, bar) do { unsigned _sp = 0; while (cond) { __builtin_amdgcn_s_sleep(1); \
    if ((++_sp & 255u) == 0u) { if (xb_ld(&(bar)[XB_TMO])) break; if (_sp > XB_SPIN_CAP) { atomicAdd(&(bar)[XB_TMO], 1u); break; } } } } while (0)

struct XcdBarrier {
    unsigned* bar; unsigned x;
    volatile LAS unsigned* st;
};

__device__ __forceinline__ XcdBarrier xcd_barrier_post(unsigned* bar, volatile LAS unsigned* st) {
    XcdBarrier b; b.bar = bar; b.x = xb_xcc_id(); b.st = st;
    if (threadIdx.x == 0) (void)xb_add(&bar[XB_XCNT(b.x)], 1u);
    return b;
}
__device__ __forceinline__ void xcd_barrier_complete(unsigned* bar, unsigned x, unsigned& nloc, unsigned& nx) {
    const unsigned G = gridDim.x * gridDim.y * gridDim.z;
    unsigned sum, cnt, mine, sp = 0u;
    for (;;) {
        sum = 0u; cnt = 0u; mine = 0u;
#pragma unroll
        for (unsigned j = 0; j < 16; ++j) { const unsigned c = xb_ld(&bar[XB_XCNT(j)]); sum += c; cnt += (c > 0u) ? 1u : 0u; mine = (j == x) ? c : mine; }
        if (sum == G) break;
        __builtin_amdgcn_s_sleep(1);
        if ((++sp & 255u) == 0u) { if (xb_ld(&bar[XB_TMO])) break; if (sp > XB_SPIN_CAP) { atomicAdd(&bar[XB_TMO], 1u); break; } }
    }
    nloc = mine > 0u ? mine : 1u; nx = cnt > 0u ? cnt : 1u;
}

__device__ __forceinline__ void xcd_barrier(const XcdBarrier& b) {
    asm volatile("s_waitcnt vmcnt(0)" ::: "memory");
    __syncthreads();
    if (threadIdx.x == 0) {
        unsigned* bar = b.bar;
        __builtin_amdgcn_s_waitcnt(0);
        unsigned nloc = b.st[0], nx = b.st[1];
        if (nloc == 0u) { xcd_barrier_complete(bar, b.x, nloc, nx); b.st[0] = nloc; b.st[1] = nx; }
        const unsigned old = xb_add(&bar[XB_XSUB(b.x)], 1u);
        const unsigned gen = old / nloc;
        if (old + 1u == (gen + 1u) * nloc) {
            __builtin_amdgcn_fence(__ATOMIC_RELEASE, "agent");
            asm volatile("s_waitcnt vmcnt(0)" ::: "memory");
            const unsigned og = xb_add(&bar[XB_TOP], 1u);
            const unsigned tg = og / nx;
            if (og + 1u == (tg + 1u) * nx) xb_add(&bar[XB_TOPGEN], 1u);
            else XB_SPIN(xb_ld(&bar[XB_TOPGEN]) == tg, bar);
            __builtin_amdgcn_fence(__ATOMIC_ACQUIRE, "agent");
            xb_add(&bar[XB_XGEN(b.x)], 1u);
            asm volatile("s_waitcnt vmcnt(0)" ::: "memory");
        } else {
            XB_SPIN(xb_ld(&bar[XB_XGEN(b.x)]) == gen, bar);
            __builtin_amdgcn_fence(__ATOMIC_ACQUIRE, "agent");
            asm volatile("s_waitcnt vmcnt(0)" ::: "memory");
        }
    }
    __syncthreads();
}

constexpr int NPHASE = 19;
__global__ void __launch_bounds__(NTHR, 2) mk(Params P, int ph_lo, int ph_hi) {
    extern __shared__ __attribute__((aligned(16))) char smem[];
    cg::grid_group grid = cg::this_grid();
    if (ph_lo > 1000) grid.sync();
    volatile LAS unsigned* xb_st = (volatile LAS unsigned*)(smem + LDS_BYTES - 16);
    if (threadIdx.x == 0) { xb_st[0] = 0u; xb_st[1] = 0u; xb_st[2] = 0u; xb_st[3] = 0u; }
    __syncthreads();
    XcdBarrier xb = xcd_barrier_post((unsigned*)(P.ws + OFF_MISC + M_BAR), xb_st);
#ifndef REP_MOE
#define REP_MOE 1
#endif
#ifndef REP_GEMM
#define REP_GEMM 1
#endif
#ifndef REP_ATT
#define REP_ATT 1
#endif
#ifndef REP_MISC
#define REP_MISC 1
#endif
#define PH(k_, body_) if (ph_lo <= (k_) && (k_) < ph_hi) { if ((k_) > ph_lo) xcd_barrier(xb); body_ }
#define RP(n_, body_) for (int rep_ = 0; rep_ < (n_); ++rep_) { body_ }
    PH(0, RP(REP_MISC, ph_prologue(P, smem);))
    PH(1, RP(REP_GEMM, ph_win_even(P, smem);))
    PH(2, RP(REP_GEMM, ph_uq(P, smem); ph_ukv(P, smem);) ph_kpe(P); RP(REP_MISC, ph_gla1(P, smem);))
    PH(3, ph_gla2(P);
          if (gridDim.x == 512) { if (((((blockIdx.x >> 8) ^ (blockIdx.x >> 3)) & 1)) == 0) conv_moe(P, 0, (float*)smem, (int)(blockIdx.x & 255), 256); }
          else conv_moe(P, 0, (float*)smem, (int)blockIdx.x, (int)gridDim.x);
          ph_attn_mla(P, smem);)
    PH(4, RP(REP_MISC, ph_gla3(P, smem);))
    PH(5, RP(REP_GEMM, ph_wo(P, 0, smem);))
    PH(6, RP(REP_MISC, ph_ln1_router(P, 0, smem);))
    PH(7, RP(REP_MISC, ph_topk(P, smem);) RP(REP_GEMM, ph_ple(P, 0, smem);))
    PH(8, ph_moe1(P, smem, 0);)
    PH(9, ph_moe2(P, smem, 0);)
    PH(10, ph_ln2(P, 0);)
    PH(11, RP(REP_GEMM, ph_win_odd(P, smem);))
    PH(12,
          if (gridDim.x == 512) { if (((((blockIdx.x >> 8) ^ (blockIdx.x >> 3)) & 1)) == 0) conv_moe(P, 1, (float*)smem, (int)(blockIdx.x & 255), 256); }
          else conv_moe(P, 1, (float*)smem, (int)blockIdx.x, (int)gridDim.x);
          ph_attn_gqa(P, smem);)
    PH(13, RP(REP_GEMM, ph_wo(P, 1, smem);))
    PH(14, RP(REP_MISC, ph_ln1_router(P, 1, smem);))
    PH(15, RP(REP_MISC, ph_topk(P, smem);) RP(REP_GEMM, ph_ple(P, 1, smem);))
    PH(16, ph_moe1(P, smem, 1);)
    PH(17, ph_moe2(P, smem, 1);)
    PH(18, ph_ln2(P, 1);)
}

extern "C" void kernel_launch(void* const* d_in, const int* in_sizes, int n_in, void* d_out, int out_size, void* d_ws, size_t ws_size, hipStream_t stream) {
    static int grid_blocks = 0;
    if (grid_blocks == 0) {
        if (n_in != 27 || ws_size < (size_t)WS_END) { fprintf(stderr, "kernel_launch: unexpected n_in %d or ws_size %zu (need %ld)\n", n_in, ws_size, (long)WS_END); grid_blocks = -1; return; }
        int dev = 0, cus = 0, per_cu = 0;
        hipGetDevice(&dev);
        hipDeviceGetAttribute(&cus, hipDeviceAttributeMultiprocessorCount, dev);
        hipFuncSetAttribute((const void*)mk, hipFuncAttributeMaxDynamicSharedMemorySize, LDS_BYTES);
        hipOccupancyMaxActiveBlocksPerMultiprocessor(&per_cu, (const void*)mk, NTHR, LDS_BYTES);
        if (per_cu < 1) { fprintf(stderr, "kernel_launch: occupancy query returned %d\n", per_cu); grid_blocks = -1; return; }
        if (per_cu > 2) per_cu = 2;
        grid_blocks = cus * per_cu;
        fprintf(stderr, "kernel_launch: cus %d per_cu %d grid %d ws %zu\n", cus, per_cu, grid_blocks, ws_size);
    }
    if (grid_blocks < 0) return;
    Params P{};
    const float** pp = (const float**)&P;
    for (int i = 0; i < 27; ++i) pp[i] = (const float*)d_in[i];
    P.out = (float*)d_out; P.ws = (char*)d_ws;
    if (hipMemsetAsync((char*)d_ws + OFF_MISC + M_BAR, 0, CTL_BYTES, stream) != hipSuccess) { fprintf(stderr, "memset failed\n"); return; }
    int lo = 0, hi = NPHASE;
    void* args[] = {&P, &lo, &hi};
    hipError_t e = hipLaunchCooperativeKernel((const void*)mk, dim3(grid_blocks), dim3(NTHR), args, LDS_BYTES, stream);
    if (e != hipSuccess) fprintf(stderr, "cooperative launch failed: %s (grid %d)\n", hipGetErrorString(e), grid_blocks);
}
```
